# Optimizing an MI355X kernel written in HIP

```python
import jax, jax.numpy as jnp
from jax import lax
import numpy as np

D_MODEL = 1024
BATCH = 8
SEQ = 2048
DEPTH = 1

N_HEADS = 8
HEAD_DIM = 64
ATTN_WIDTH = N_HEADS * HEAD_DIM
IDX_HEADS = 8
IDX_DIM = 64
INDEX_TOPK_MAX = 256
CONV_WIDTH = 512
CONV_GROUPS = 8
CONV_K = 3
N_BRANCHES = 2
D_FF = 2816
FFN_CONV_K = 3
Q_BLOCK = 64
EPS = 1e-6

kernel_name = "hybrid_gated_dsa_shortconv_convffn"

SPLIT_SIZES = (
    ATTN_WIDTH,
    ATTN_WIDTH,
    ATTN_WIDTH,
    IDX_HEADS * IDX_DIM,
    IDX_DIM,
    IDX_HEADS,
    CONV_WIDTH,
    CONV_WIDTH,
    CONV_WIDTH,
    N_BRANCHES * D_MODEL,
)
IN_COLS = sum(SPLIT_SIZES)


def rms_norm(x, g):
    xf = x.astype(jnp.float32)
    y = xf * lax.rsqrt(jnp.mean(xf * xf, axis=-1, keepdims=True) + EPS)
    return (y * g.astype(jnp.float32)).astype(x.dtype)


def causal_dwconv(u, w):
    ksz = w.shape[0]
    s = u.shape[1]
    up = jnp.pad(u, ((0, 0), (ksz - 1, 0), (0, 0)))
    y = up[:, 0:s] * w[0]
    for j in range(1, ksz):
        y = y + up[:, j:j + s] * w[j]
    return y


def sparse_attention(q, k, v, iq, ik, iw):
    b, s = q.shape[0], q.shape[1]
    topk = min(INDEX_TOPK_MAX, s // 4)
    nb = s // Q_BLOCK
    scale = HEAD_DIM ** -0.5
    iw = iw.astype(jnp.float32) * (IDX_HEADS ** -0.5) * (IDX_DIM ** -0.5)
    ikf = ik.astype(jnp.float32)
    key_pos = jnp.arange(s)

    def to_blocks(a):
        return a.reshape((b, nb, Q_BLOCK) + a.shape[2:]).swapaxes(0, 1)

    starts = jnp.arange(nb) * Q_BLOCK

    def block(args):
        qb, iqb, iwb, start = args
        qpos = start + jnp.arange(Q_BLOCK)
        causal = key_pos[None, :] <= qpos[:, None]
        dots = jnp.einsum('bqhd,bsd->bqhs', iqb.astype(jnp.float32), ikf)
        score = jnp.einsum('bqhs,bqh->bqs', jax.nn.relu(dots), iwb)
        score = jnp.where(causal[None], score, -jnp.inf)
        top_val, top_idx = lax.top_k(score, topk)
        valid = jnp.isfinite(top_val)
        k_sel = jax.vmap(lambda kb, ib: kb[ib])(k, top_idx)
        v_sel = jax.vmap(lambda vb, ib: vb[ib])(v, top_idx)
        logits = jnp.einsum('bqhd,bqkhd->bqhk', qb, k_sel).astype(jnp.float32) * scale
        logits = jnp.where(valid[:, :, None, :], logits, -jnp.inf)
        p = jax.nn.softmax(logits, axis=-1).astype(v.dtype)
        return jnp.einsum('bqhk,bqkhd->bqhd', p, v_sel)

    out = lax.map(block, (to_blocks(q), to_blocks(iq), to_blocks(iw), starts))
    return out.swapaxes(0, 1).reshape(b, s, N_HEADS * HEAD_DIM)


def setup_inputs(seed: int = 0) -> dict:
    key = jax.random.key(seed)
    ks = jax.random.split(key, 16)
    f32 = jnp.float32

    def nrm(k, shape, scale):
        return jax.random.normal(k, shape, f32) * scale

    return {
        "x": jax.random.normal(ks[0], (BATCH, SEQ, D_MODEL), f32),
        "norm_mix_g": 1.0 + nrm(ks[1], (DEPTH, D_MODEL), 0.02),
        "w_in": nrm(ks[2], (DEPTH, D_MODEL, IN_COLS), D_MODEL ** -0.5),
        "b_gate": nrm(ks[3], (DEPTH, N_BRANCHES * D_MODEL), 0.02),
        "w_attn_out": nrm(ks[4], (DEPTH, ATTN_WIDTH, D_MODEL), ATTN_WIDTH ** -0.5),
        "conv_w": nrm(ks[5], (DEPTH, CONV_K, CONV_WIDTH), CONV_K ** -0.5),
        "w_conv_out": nrm(ks[6], (DEPTH, CONV_WIDTH, D_MODEL), CONV_WIDTH ** -0.5),
        "w_o": nrm(ks[7], (DEPTH, D_MODEL, D_MODEL), D_MODEL ** -0.5),
        "norm_ffn_g": 1.0 + nrm(ks[8], (DEPTH, D_MODEL), 0.02),
        "w_up": nrm(ks[9], (DEPTH, D_MODEL, 2 * D_FF), D_MODEL ** -0.5),
        "ffn_conv_w": nrm(ks[10], (DEPTH, FFN_CONV_K, 2 * D_FF), FFN_CONV_K ** -0.5),
        "w_down": nrm(ks[11], (DEPTH, D_FF, D_MODEL), D_FF ** -0.5),
        "norm_final_g": 1.0 + nrm(ks[12], (D_MODEL,), 0.02),
    }


def reference(x, norm_mix_g, w_in, b_gate, w_attn_out, conv_w, w_conv_out, w_o,
              norm_ffn_g, w_up, ffn_conv_w, w_down, norm_final_g):
    b, s, _ = x.shape
    split_points = list(np.cumsum(SPLIT_SIZES)[:-1])
    h = x
    for l in range(DEPTH):
        xn = rms_norm(h, norm_mix_g[l])
        proj = jnp.einsum('bsd,dc->bsc', xn, w_in[l])
        q, k, v, iq, ik, iw, ch, cb, cc, gates = jnp.split(proj, split_points, axis=-1)
        q = q.reshape(b, s, N_HEADS, HEAD_DIM)
        k = k.reshape(b, s, N_HEADS, HEAD_DIM)
        v = v.reshape(b, s, N_HEADS, HEAD_DIM)
        iq = iq.reshape(b, s, IDX_HEADS, IDX_DIM)
        attn = sparse_attention(q, k, v, iq, ik, iw)
        branch_a = jnp.einsum('bsc,cd->bsd', attn, w_attn_out[l])
        conv = causal_dwconv(cc * ch, conv_w[l])
        branch_c = jnp.einsum('bsc,cd->bsd', cb * conv, w_conv_out[l])
        g = jax.nn.sigmoid(gates + b_gate[l])
        g_a, g_c = jnp.split(g, N_BRANCHES, axis=-1)
        merged = g_a * branch_a + g_c * branch_c
        h = h + jnp.einsum('bsd,de->bse', merged, w_o[l])
        xn2 = rms_norm(h, norm_ffn_g[l])
        up = jnp.einsum('bsd,df->bsf', xn2, w_up[l])
        up = causal_dwconv(up, ffn_conv_w[l])
        gt, val = jnp.split(up, 2, axis=-1)
        h = h + jnp.einsum('bsf,fd->bsd', jax.nn.silu(gt) * val, w_down[l])
    return rms_norm(h, norm_final_g)
```

```cpp
#include <hip/hip_runtime.h>
#include <cstdio>
#include <cstdint>
namespace pg8 {
#define PG8_LAS __attribute__((address_space(3)))
typedef unsigned short bf16_t;
typedef short bf16x8 __attribute__((ext_vector_type(8)));
typedef float f32x4 __attribute__((ext_vector_type(4)));
typedef unsigned u32x4 __attribute__((ext_vector_type(4)));
constexpr int BM = 256, BK = 64, HALF = 128, HTB = HALF * BK * 2  , STAGE_BYTES = 8 * HTB, NXCD = 8, WGM = 8;

__host__ __device__ __forceinline__ int lds_byte(int r, int c) { const int st = (r >> 4) * 2 + (c >> 5), rr = r & 15, cc = c & 31, ob = rr * 64 + cc * 2; return st * 1024 + (ob ^ (((ob >> 9) & 1) << 5)); }
__host__ __device__ __forceinline__ void stage_rc(int b, int& R, int& C) { const int st = b / 1024, sb = b % 1024, swz = sb ^ (((sb >> 9) & 1) << 5); R = (st >> 1) * 16 + swz / 64; C = (st & 1) * 32 + (swz % 64) / 2; }
__host__ __device__ __forceinline__ int perm32(int rho) { const int n = rho >> 4, i = rho & 15; return 8 * (i >> 2) + 4 * n + (i & 3); }

struct Unit { int pm, pn; };
struct Gemm { const bf16_t* A; const bf16_t* Bt; int M, N, K, lda, ldb; };

struct StaticOrder {
    int nM, nN, nwg, G, c;
    __host__ __device__ void init(int M, int N, int G_, int c_) { nM = M / BM; nN = N / BM; nwg = nM * nN; G = G_; c = c_; }
    __host__ __device__ bool next(int i, Unit& u) const {
        const long L = (long)i * G + c; if (L >= nwg) return false;
        int wgid = (int)L; { const int q = nwg / NXCD, r = nwg % NXCD, xcd = wgid % NXCD, off = wgid / NXCD; wgid = (xcd < r ? xcd * (q + 1) : r * (q + 1) + (xcd - r) * q) + off; }
        const int nig = WGM * nN, gid = wgid / nig, fm = gid * WGM, gsz = (nM - fm) < WGM ? (nM - fm) : WGM;
        u.pm = fm + ((wgid % nig) % gsz); u.pn = (wgid % nig) / gsz; return true;
    }
    __device__ __forceinline__ void a_ready(const Unit&) const {}
    __device__ __forceinline__ void done(const Unit&) const {}
};

__device__ __forceinline__ unsigned cvt_pk_bf16(float lo, float hi) { unsigned r; asm volatile("v_cvt_pk_bf16_f32 %0, %1, %2" : "=v"(r) : "v"(lo), "v"(hi)); return r; }
template <class Epi, class Sched, bool ALIGN_EPI = false, bool SP2 = false>
__device__ __forceinline__ void gemm_phase(PG8_LAS unsigned char* lds, const Gemm g, const Sched& S, const Epi& E) {
    const int tid = threadIdx.x, wid = __builtin_amdgcn_readfirstlane(tid >> 6), lane = tid & 63, wr = wid >> 2, wc = wid & 3, fr = lane & 15, fq = lane >> 4;
    const int K = g.K, nt = K / BK;
    unsigned voffA[2], voffB[2];
#pragma unroll
    for (int i = 0; i < 2; ++i) { int R, C; stage_rc(tid * 16 + i * 8192, R, C); const int Rb = Epi::PERM ? ((R & ~31) + perm32(R & 31)) : R;
        voffA[i] = (unsigned)(R * g.lda + C) * 2u; voffB[i] = (unsigned)(Rb * g.ldb + C) * 2u; }
    const size_t kstep = (size_t)(BK * 2);
    const size_t hstepA = (size_t)HALF * g.lda * 2, hstepB = (size_t)HALF * g.ldb * 2;
    const size_t tstepA = 2 * hstepA, tstepB = 2 * hstepB;
    const unsigned ldsw = (unsigned)wid * 1024u;
    const int aoff = lds_byte(wr * 64 + fr, fq * 8), boff = lds_byte(wc * 32 + fr, fq * 8);
#define PG8_SA(b, h) (((b) * 2 + (h)) * HTB)
#define PG8_SB(b, h) ((4 + (b) * 2 + (h)) * HTB)
#define PG8_STAGE(bufoff, gbase, voff) do { _Pragma("unroll") for (int _i = 0; _i < 2; ++_i) \
        __builtin_amdgcn_global_load_lds((const unsigned*)((const char*)(gbase) + (voff)[_i]), (PG8_LAS unsigned*)(lds + (bufoff) + ldsw + _i * 8192), 16, 0, 0); } while (0)
#define PG8_LDA(dst, b, h) do { _Pragma("unroll") for (int m = 0; m < 4; ++m) _Pragma("unroll") for (int k = 0; k < 2; ++k) dst[m][k] = *(const PG8_LAS bf16x8*)(lds + PG8_SA(b, h) + aoff + m * 2048 + k * 1024); } while (0)
#define PG8_LDB(dst, b, h) do { _Pragma("unroll") for (int n = 0; n < 2; ++n) _Pragma("unroll") for (int k = 0; k < 2; ++k) dst[n][k] = *(const PG8_LAS bf16x8*)(lds + PG8_SB(b, h) + boff + n * 2048 + k * 1024); } while (0)
#define PG8_MMA(ai, bj, At, Bt) do { __builtin_amdgcn_s_setprio(1); _Pragma("unroll") for (int m = 0; m < 4; ++m) _Pragma("unroll") for (int n = 0; n < 2; ++n) _Pragma("unroll") for (int k = 0; k < 2; ++k) \
        acc[ai][bj][m][n] = __builtin_amdgcn_mfma_f32_16x16x32_bf16(Bt[n][k], At[m][k], acc[ai][bj][m][n], 0, 0, 0); __builtin_amdgcn_s_setprio(0); } while (0)
#define PG8_WAIT_V(n) asm volatile("s_waitcnt vmcnt(" #n ")" ::: "memory")
#define PG8_WAIT_L(n) asm volatile("s_waitcnt lgkmcnt(" #n ")" ::: "memory")
#define PG8_BAR __builtin_amdgcn_s_barrier()
#define PG8_SCHED __builtin_amdgcn_sched_barrier(0)
    Unit cur, nxt; int ui = 0;
    if (!S.next(0, cur)) return;
    f32x4 acc[2][2][4][2];
#pragma unroll
    for (int a = 0; a < 2; ++a)
#pragma unroll
        for (int b = 0; b < 2; ++b)
#pragma unroll
            for (int m = 0; m < 4; ++m)
#pragma unroll
                for (int n = 0; n < 2; ++n) acc[a][b][m][n] = (f32x4){0.f, 0.f, 0.f, 0.f};
    bf16x8 At[4][2], B0[2][2], B1[2][2];
    const char* cA = (const char*)g.A + (size_t)cur.pm * tstepA; const char* cB = (const char*)g.Bt + (size_t)cur.pn * tstepB;
    S.a_ready(cur);
    if constexpr (SP2) {
        PG8_STAGE(PG8_SB(0, 0), cB, voffB); PG8_STAGE(PG8_SB(0, 1), cB + hstepB, voffB); PG8_STAGE(PG8_SA(0, 0), cA, voffA); PG8_STAGE(PG8_SA(0, 1), cA + hstepA, voffA);
        if (wr == 1) PG8_BAR;
        PG8_WAIT_V(2); PG8_BAR;
        PG8_STAGE(PG8_SB(1, 0), cB + kstep, voffB); PG8_STAGE(PG8_SA(1, 0), cA + kstep, voffA); PG8_STAGE(PG8_SB(1, 1), cB + hstepB + kstep, voffB);
        PG8_WAIT_V(6); PG8_BAR;
    } else {
        PG8_STAGE(PG8_SB(0, 0), cB, voffB); PG8_STAGE(PG8_SA(0, 0), cA, voffA); PG8_STAGE(PG8_SB(0, 1), cB + hstepB, voffB); PG8_STAGE(PG8_SA(0, 1), cA + hstepA, voffA);
        if (wr == 1) PG8_BAR;
        PG8_WAIT_V(4); PG8_BAR;
        PG8_STAGE(PG8_SB(1, 0), cB + kstep, voffB); PG8_STAGE(PG8_SA(1, 0), cA + kstep, voffA); PG8_STAGE(PG8_SB(1, 1), cB + hstepB + kstep, voffB);
        PG8_WAIT_V(6); PG8_BAR;
    }
    for (;;) {
        const bool has_next = S.next(ui + 1, nxt);
        const char* nA = has_next ? (const char*)g.A + (size_t)nxt.pm * tstepA : cA; const char* nB = has_next ? (const char*)g.Bt + (size_t)nxt.pn * tstepB : cB;
        for (int t = 0; t < nt; t += 2) {
            const bool last = (t == nt - 2);
            const char* a1 = cA + (size_t)(t + 1) * kstep;
            const char* a2 = last ? nA : cA + (size_t)(t + 2) * kstep; const char* b2 = last ? nB : cB + (size_t)(t + 2) * kstep;
            const char* a3 = a2 + kstep; const char* b3 = b2 + kstep;
            if (last && has_next) S.a_ready(nxt);
            if constexpr (SP2) {
            PG8_LDB(B0, 0, 0); PG8_LDB(B1, 0, 1); PG8_SCHED; PG8_LDA(At, 0, 0); PG8_STAGE(PG8_SA(1, 1), a1 + hstepA, voffA);
            PG8_WAIT_V(8); PG8_WAIT_L(0); PG8_BAR; PG8_MMA(0, 0, At, B0); PG8_MMA(0, 1, At, B1); PG8_BAR; PG8_SCHED;
            PG8_LDA(At, 0, 1); PG8_STAGE(PG8_SB(0, 0), b2, voffB); PG8_STAGE(PG8_SB(0, 1), b2 + hstepB, voffB); PG8_STAGE(PG8_SA(0, 0), a2, voffA);
            PG8_WAIT_V(8); PG8_WAIT_L(0); PG8_BAR; PG8_MMA(1, 0, At, B0); PG8_MMA(1, 1, At, B1); PG8_BAR; PG8_SCHED;
            PG8_LDB(B0, 1, 0); PG8_LDB(B1, 1, 1); PG8_SCHED; PG8_LDA(At, 1, 0); PG8_STAGE(PG8_SA(0, 1), a2 + hstepA, voffA);
            PG8_WAIT_V(8); PG8_WAIT_L(0); PG8_BAR; PG8_MMA(0, 0, At, B0); PG8_MMA(0, 1, At, B1); PG8_BAR; PG8_SCHED;
            PG8_LDA(At, 1, 1); PG8_STAGE(PG8_SB(1, 0), b3, voffB); PG8_STAGE(PG8_SB(1, 1), b3 + hstepB, voffB); PG8_STAGE(PG8_SA(1, 0), a3, voffA);
            PG8_WAIT_V(8); PG8_WAIT_L(0); PG8_BAR; PG8_MMA(1, 0, At, B0); PG8_MMA(1, 1, At, B1); PG8_BAR; PG8_SCHED;
            } else {
            PG8_LDB(B0, 0, 0); PG8_SCHED; PG8_LDA(At, 0, 0); PG8_STAGE(PG8_SA(1, 1), a1 + hstepA, voffA);
            PG8_WAIT_L(8); PG8_BAR; PG8_WAIT_L(0); PG8_MMA(0, 0, At, B0); PG8_BAR; PG8_SCHED;
            PG8_LDB(B1, 0, 1); PG8_STAGE(PG8_SB(0, 0), b2, voffB);
            PG8_BAR; PG8_WAIT_L(0); PG8_MMA(0, 1, At, B1); PG8_BAR;
            PG8_LDA(At, 0, 1); PG8_STAGE(PG8_SA(0, 0), a2, voffA);
            PG8_BAR; PG8_WAIT_L(0); PG8_MMA(1, 0, At, B0); PG8_BAR; PG8_SCHED;
            PG8_STAGE(PG8_SB(0, 1), b2 + hstepB, voffB);
            PG8_WAIT_V(6); PG8_BAR; PG8_MMA(1, 1, At, B1); PG8_BAR;
            PG8_LDB(B0, 1, 0); PG8_SCHED; PG8_LDA(At, 1, 0); PG8_STAGE(PG8_SA(0, 1), a2 + hstepA, voffA);
            PG8_WAIT_L(8); PG8_BAR; PG8_WAIT_L(0); PG8_MMA(0, 0, At, B0); PG8_BAR; PG8_SCHED;
            PG8_LDB(B1, 1, 1); PG8_STAGE(PG8_SB(1, 0), b3, voffB);
            PG8_BAR; PG8_WAIT_L(0); PG8_MMA(0, 1, At, B1); PG8_BAR;
            PG8_LDA(At, 1, 1); PG8_STAGE(PG8_SA(1, 0), a3, voffA);
            PG8_BAR; PG8_WAIT_L(0); PG8_MMA(1, 0, At, B0); PG8_BAR; PG8_SCHED;
            PG8_STAGE(PG8_SB(1, 1), b3 + hstepB, voffB);
            PG8_WAIT_V(6); PG8_BAR; PG8_MMA(1, 1, At, B1); PG8_BAR;
            }
        }
        if constexpr (ALIGN_EPI) { if (wr == 0) PG8_BAR; }
        if constexpr (!Epi::AFTER_DRAIN) { E(acc, cur, wr, wc, fr, fq); S.done(cur); }
        if (!has_next) break;
#pragma unroll
        for (int a = 0; a < 2; ++a)
#pragma unroll
            for (int b = 0; b < 2; ++b)
#pragma unroll
                for (int m = 0; m < 4; ++m)
#pragma unroll
                    for (int n = 0; n < 2; ++n) acc[a][b][m][n] = (f32x4){0.f, 0.f, 0.f, 0.f};
        cur = nxt; cA = nA; cB = nB; ++ui;
        if constexpr (ALIGN_EPI) { if (wr == 1) PG8_BAR; }
    }
    PG8_WAIT_V(0);
    if constexpr (!ALIGN_EPI) { if (wr == 0) PG8_BAR; }
    PG8_BAR;
    if constexpr (Epi::AFTER_DRAIN) { E.fused(acc, cur, wr, wc, fr, fq, lds, wid, lane); S.done(cur); }
#undef PG8_SA
#undef PG8_SB
#undef PG8_STAGE
#undef PG8_LDA
#undef PG8_LDB
#undef PG8_MMA
#undef PG8_WAIT_V
#undef PG8_WAIT_L
#undef PG8_BAR
#undef PG8_SCHED
}
}

constexpr int BATCH = 8, SEQ = 2048, DM = 1024, M = BATCH * SEQ;
constexpr int NH = 8, HD = 64, AW = NH * HD, IH = 8, ID = 64, TOPK = 256, CWID = 512, DFF = 2816;
constexpr int IN_COLS = 5704, NP1 = 5888;
constexpr float EPS = 1e-6f;
constexpr float C2 = 0.125f * 1.4426950408889634f;
constexpr float IWSCALE = 0.04419417382415922f;
constexpr int NTILE = SEQ / 64;

constexpr size_t MiB = 1u << 20;
constexpr size_t WS_CTL = 0, CTL_ZERO_BYTES = 1 * MiB;
constexpr size_t WS_WIN = 2 * MiB, WS_WCAT = 14 * MiB, WS_WO = 16 * MiB, WS_WUP = 18 * MiB, WS_WDN = 29 * MiB;
constexpr size_t WS_XN = 36 * MiB;
constexpr size_t WS_IQ = 68 * MiB, WS_CH = 84 * MiB, WS_CC = 100 * MiB;
constexpr size_t WS_AC = 116 * MiB;
constexpr size_t WS_KV = 148 * MiB;
constexpr size_t WS_G = 180 * MiB;
constexpr size_t WS_IK = 244 * MiB, WS_IW = 246 * MiB;
constexpr size_t WS_MASK = 247 * MiB;
constexpr size_t WS_END = 256 * MiB;
constexpr size_t WS_T1 = 36 * MiB;
constexpr size_t WS_MRG = 148 * MiB;
constexpr size_t WS_XN2 = 36 * MiB;
constexpr size_t WS_ACT = 68 * MiB;
constexpr size_t WS_UPR = 156 * MiB;
constexpr int CW_TMO = 0, CW_CODE = 1;
constexpr int CW_BAR = 4096;

constexpr int RING_OFF = 0, RING_BYTES = 131072;
constexpr int LDSCTL_OFF = 155648, MISC_OFF = LDSCTL_OFF + 320;
constexpr int LDS_BYTES = 163840;
constexpr int NWAVES = 8;

#define GAS __attribute__((address_space(1)))
#define LAS __attribute__((address_space(3)))
typedef unsigned short bf16;
typedef unsigned v4u __attribute__((ext_vector_type(4)));
typedef unsigned v2u __attribute__((ext_vector_type(2)));
typedef float f32x4 __attribute__((ext_vector_type(4)));
typedef GAS unsigned gu32;
#define RLX_AGENT __ATOMIC_RELAXED, __HIP_MEMORY_SCOPE_AGENT
#define LDS_WAIT() asm volatile("s_waitcnt lgkmcnt(0)" ::: "memory")
#define VM_WAIT() asm volatile("s_waitcnt vmcnt(0)" ::: "memory")
__device__ __forceinline__ unsigned f2bf(float f) { unsigned u = __builtin_bit_cast(unsigned, f); return (u + 0x7fffu + ((u >> 16) & 1u)) >> 16; }
__device__ __forceinline__ unsigned pk2(float lo, float hi) { return f2bf(lo) | (f2bf(hi) << 16); }
__device__ __forceinline__ float bflo(unsigned w) { return __builtin_bit_cast(float, w << 16); }
__device__ __forceinline__ float bfhi(unsigned w) { return __builtin_bit_cast(float, w & 0xffff0000u); }
__device__ __forceinline__ float bf2f(bf16 h) { return __builtin_bit_cast(float, (unsigned)h << 16); }
__device__ __forceinline__ float wave_sum(float v) {
#pragma unroll
    for (int o = 1; o < 64; o <<= 1) v += __shfl_xor(v, o);
    return v;
}
__device__ __forceinline__ float wave_max(float v) {
#pragma unroll
    for (int o = 1; o < 64; o <<= 1) v = fmaxf(v, __shfl_xor(v, o));
    return v;
}
__device__ __forceinline__ float sigmoidf_(float x) { return __builtin_amdgcn_rcpf(1.0f + __builtin_amdgcn_exp2f(-1.4426950408889634f * x)); }

#define XB_TMO      128
#define XB_XCNT(j)  (256  + 64 * (j))
#define XB_XSUB(j)  (1280 + 64 * (j))
#define XB_XGEN(j)  (2304 + 64 * (j))
#define XB_TOP      3328
#define XB_TOPGEN   3392
#define XCD_BAR_WORDS 3456
#define XB_SPIN_CAP (1u << 18)

__device__ __forceinline__ unsigned xb_ld(unsigned* p)              { return __hip_atomic_load(p, __ATOMIC_RELAXED, __HIP_MEMORY_SCOPE_AGENT); }
__device__ __forceinline__ unsigned xb_add(unsigned* p, unsigned v) { return __hip_atomic_fetch_add(p, v, __ATOMIC_RELAXED, __HIP_MEMORY_SCOPE_AGENT); }
__device__ __forceinline__ unsigned xb_xcc_id() { return (unsigned)__builtin_amdgcn_s_getreg((3 << 11) | 20) & 0xFu; }
#define XB_SPIN(cond, bar) do { unsigned _sp = 0; while (cond) { __builtin_amdgcn_s_sleep(1); \
    if ((++_sp & 255u) == 0u) { if (xb_ld(&(bar)[XB_TMO])) break; if (_sp > XB_SPIN_CAP) { atomicAdd(&(bar)[XB_TMO], 1u); break; } } } } while (0)

struct XcdBarrier {
    unsigned* bar; unsigned x;
    volatile LAS unsigned* st;
};

__device__ __forceinline__ XcdBarrier xcd_barrier_post(unsigned* bar, volatile LAS unsigned* st) {
    XcdBarrier b; b.bar = bar; b.x = xb_xcc_id(); b.st = st;
    if (threadIdx.x == 0) (void)xb_add(&bar[XB_XCNT(b.x)], 1u);
    return b;
}
__device__ __forceinline__ void xcd_barrier_complete(unsigned* bar, unsigned x, unsigned& nloc, unsigned& nx) {
    const unsigned G = gridDim.x * gridDim.y * gridDim.z;
    unsigned sum, cnt, mine, sp = 0u;
    for (;;) {
        sum = 0u; cnt = 0u; mine = 0u;
#pragma unroll
        for (unsigned j = 0; j < 16; ++j) { const unsigned c = xb_ld(&bar[XB_XCNT(j)]); sum += c; cnt += (c > 0u) ? 1u : 0u; mine = (j == x) ? c : mine; }
        if (sum == G) break;
        __builtin_amdgcn_s_sleep(1);
        if ((++sp & 255u) == 0u) { if (xb_ld(&bar[XB_TMO])) break; if (sp > XB_SPIN_CAP) { atomicAdd(&bar[XB_TMO], 1u); break; } }
    }
    nloc = mine > 0u ? mine : 1u; nx = cnt > 0u ? cnt : 1u;
}

__device__ __forceinline__ void xcd_barrier(const XcdBarrier& b) {
    asm volatile("s_waitcnt vmcnt(0)" ::: "memory");
    __syncthreads();
    if (threadIdx.x == 0) {
        unsigned* bar = b.bar;
        __builtin_amdgcn_s_waitcnt(0);
        unsigned nloc = b.st[0], nx = b.st[1];
        if (nloc == 0u) { xcd_barrier_complete(bar, b.x, nloc, nx); b.st[0] = nloc; b.st[1] = nx; }
        const unsigned old = xb_add(&bar[XB_XSUB(b.x)], 1u);
        const unsigned gen = old / nloc;
        if (old + 1u == (gen + 1u) * nloc) {
            __builtin_amdgcn_fence(__ATOMIC_RELEASE, "agent");
            asm volatile("s_waitcnt vmcnt(0)" ::: "memory");
            const unsigned og = xb_add(&bar[XB_TOP], 1u);
            const unsigned tg = og / nx;
            if (og + 1u == (tg + 1u) * nx) xb_add(&bar[XB_TOPGEN], 1u);
            else XB_SPIN(xb_ld(&bar[XB_TOPGEN]) == tg, bar);
            __builtin_amdgcn_fence(__ATOMIC_ACQUIRE, "agent");
            xb_add(&bar[XB_XGEN(b.x)], 1u);
            asm volatile("s_waitcnt vmcnt(0)" ::: "memory");
        } else {
            XB_SPIN(xb_ld(&bar[XB_XGEN(b.x)]) == gen, bar);
            __builtin_amdgcn_fence(__ATOMIC_ACQUIRE, "agent");
            asm volatile("s_waitcnt vmcnt(0)" ::: "memory");
        }
    }
    __syncthreads();
}

using pg8::Unit;
typedef float f32x2_t __attribute__((ext_vector_type(2))); typedef __bf16 bf16x2_t __attribute__((ext_vector_type(2)));
__device__ __forceinline__ unsigned cvtpk(float lo, float hi) { const f32x2_t v = {lo, hi}; const bf16x2_t b = __builtin_convertvector(v, bf16x2_t); return __builtin_bit_cast(unsigned, b); }
__device__ __forceinline__ v4u pack8(const f32x4 a, const f32x4 b) { v4u w; w.x = cvtpk(a[0], a[1]); w.y = cvtpk(a[2], a[3]); w.z = cvtpk(b[0], b[1]); w.w = cvtpk(b[2], b[3]); return w; }
__device__ __forceinline__ void unpack8(const v4u g, f32x4& a, f32x4& b) { a = (f32x4){bflo(g.x), bfhi(g.x), bflo(g.y), bfhi(g.y)}; b = (f32x4){bflo(g.z), bfhi(g.z), bflo(g.w), bfhi(g.w)}; }

struct EpiProj {
    static constexpr bool PERM = true, AFTER_DRAIN = false;
    bf16 *AC, *KV, *IQ, *CH, *CC, *G, *IK; float* IW; const float* bgate;
    __device__ __forceinline__ void operator()(const f32x4 (&acc)[2][2][4][2], const Unit& u, int wr, int wc, int fr, int fq) const {
        const int pn = u.pn, row0 = u.pm * 256 + wr * 64 + fr, cin = wc * 32 + 8 * fq;
        if (pn < 14) {
            const int seg = pn >> 1; bf16* base; int ldc = 1024; float sc = 1.f;
            if (seg == 0) { base = AC; sc = C2; } else if (seg == 1) { base = KV; } else if (seg == 2) { base = KV + 512; }
            else if (seg == 3) { base = IQ; ldc = 512; } else if (seg == 4) { base = CH; ldc = 512; } else if (seg == 5) { base = AC + 512; } else { base = CC; ldc = 512; }
            base += (pn & 1) * 256 + cin;
#pragma unroll
            for (int ai = 0; ai < 2; ++ai)
#pragma unroll
                for (int m = 0; m < 4; ++m) { bf16* rowp = base + (size_t)(row0 + ai * 128 + m * 16) * ldc;
#pragma unroll
                    for (int bj = 0; bj < 2; ++bj) *(v4u*)(rowp + bj * 128) = pack8(acc[ai][bj][m][0] * sc, acc[ai][bj][m][1] * sc); }
        } else if (pn < 22) {
            const int gc = (pn - 14) * 256 + cin;
            f32x4 bv[2][2];
#pragma unroll
            for (int bj = 0; bj < 2; ++bj)
#pragma unroll
                for (int n = 0; n < 2; ++n) bv[bj][n] = *(const f32x4*)(bgate + gc + bj * 128 + 4 * n);
#pragma unroll
            for (int ai = 0; ai < 2; ++ai)
#pragma unroll
                for (int m = 0; m < 4; ++m) { bf16* rowp = G + (size_t)(row0 + ai * 128 + m * 16) * 2048 + gc;
#pragma unroll
                    for (int bj = 0; bj < 2; ++bj) { f32x4 v0 = acc[ai][bj][m][0] + bv[bj][0], v1 = acc[ai][bj][m][1] + bv[bj][1];
#pragma unroll
                        for (int e = 0; e < 4; ++e) { v0[e] = sigmoidf_(v0[e]); v1[e] = sigmoidf_(v1[e]); }
                        *(v4u*)(rowp + bj * 128) = pack8(v0, v1); } }
        } else {
            if (wc < 2) {
#pragma unroll
                for (int ai = 0; ai < 2; ++ai)
#pragma unroll
                    for (int m = 0; m < 4; ++m) *(v4u*)(IK + (size_t)(row0 + ai * 128 + m * 16) * 64 + cin) = pack8(acc[ai][0][m][0], acc[ai][0][m][1]);
            } else if (wc == 2 && fq == 0) {
#pragma unroll
                for (int ai = 0; ai < 2; ++ai)
#pragma unroll
                    for (int m = 0; m < 4; ++m) { float* p = IW + (size_t)(row0 + ai * 128 + m * 16) * 8; *(f32x4*)p = acc[ai][0][m][0] * IWSCALE; *(f32x4*)(p + 4) = acc[ai][0][m][1] * IWSCALE; }
            }
        }
    }
};
struct EpiGateA {
    static constexpr bool PERM = true, AFTER_DRAIN = false;
    float* T1; const bf16* G;
    __device__ __forceinline__ void operator()(const f32x4 (&acc)[2][2][4][2], const Unit& u, int wr, int wc, int fr, int fq) const {
        const int row0 = u.pm * 256 + wr * 64 + fr, c0 = u.pn * 256 + wc * 32 + 8 * fq;
#pragma unroll
        for (int ai = 0; ai < 2; ++ai)
#pragma unroll
            for (int m = 0; m < 4; ++m) { const int row = row0 + ai * 128 + m * 16;
#pragma unroll
                for (int bj = 0; bj < 2; ++bj) { const int col = c0 + bj * 128; f32x4 g0, g1; unpack8(*(const v4u*)(G + (size_t)row * 2048 + col), g0, g1);
                    float* p = T1 + (size_t)row * 1024 + col; *(f32x4*)p = acc[ai][bj][m][0] * g0; *(f32x4*)(p + 4) = acc[ai][bj][m][1] * g1; }
                asm volatile("" ::: "memory"); }
    }
};
struct EpiGateC {
    static constexpr bool PERM = true, AFTER_DRAIN = false;
    const float* T1; const bf16* G; bf16* MRG;
    __device__ __forceinline__ void operator()(const f32x4 (&acc)[2][2][4][2], const Unit& u, int wr, int wc, int fr, int fq) const {
        const int row0 = u.pm * 256 + wr * 64 + fr, c0 = u.pn * 256 + wc * 32 + 8 * fq;
#pragma unroll
        for (int ai = 0; ai < 2; ++ai)
#pragma unroll
            for (int m = 0; m < 4; ++m) { const int row = row0 + ai * 128 + m * 16;
#pragma unroll
                for (int bj = 0; bj < 2; ++bj) { const int col = c0 + bj * 128; f32x4 g0, g1; unpack8(*(const v4u*)(G + (size_t)row * 2048 + 1024 + col), g0, g1);
                    const float* p = T1 + (size_t)row * 1024 + col; const f32x4 t0 = *(const f32x4*)p, t1 = *(const f32x4*)(p + 4);
                    *(v4u*)(MRG + (size_t)row * 1024 + col) = pack8(t0 + acc[ai][bj][m][0] * g0, t1 + acc[ai][bj][m][1] * g1); }
                asm volatile("" ::: "memory"); }
    }
};
struct EpiResid {
    static constexpr bool PERM = false, AFTER_DRAIN = false;
    const float* X; float* O;
    __device__ __forceinline__ void operator()(const f32x4 (&acc)[2][2][4][2], const Unit& u, int wr, int wc, int fr, int fq) const {
        const int row0 = u.pm * 256 + wr * 64 + fr, c0 = u.pn * 256 + wc * 32 + 4 * fq;
#pragma unroll
        for (int ai = 0; ai < 2; ++ai)
#pragma unroll
            for (int m = 0; m < 4; ++m) { const size_t off = (size_t)(row0 + ai * 128 + m * 16) * 1024 + c0;
#pragma unroll
                for (int bj = 0; bj < 2; ++bj)
#pragma unroll
                    for (int n = 0; n < 2; ++n) { const f32x4 xv = *(const f32x4*)(X + off + bj * 128 + n * 16); *(f32x4*)(O + off + bj * 128 + n * 16) = xv + acc[ai][bj][m][n]; }
                asm volatile("" ::: "memory"); }
    }
};
struct EpiRawBf16 {
    static constexpr bool PERM = true, AFTER_DRAIN = false;
    bf16* O; int ldc;
    __device__ __forceinline__ void operator()(const f32x4 (&acc)[2][2][4][2], const Unit& u, int wr, int wc, int fr, int fq) const {
        const int row0 = u.pm * 256 + wr * 64 + fr, c0 = u.pn * 256 + wc * 32 + 8 * fq;
#pragma unroll
        for (int ai = 0; ai < 2; ++ai)
#pragma unroll
            for (int m = 0; m < 4; ++m) { bf16* rowp = O + (size_t)(row0 + ai * 128 + m * 16) * ldc + c0;
#pragma unroll
                for (int bj = 0; bj < 2; ++bj) *(v4u*)(rowp + bj * 128) = pack8(acc[ai][bj][m][0], acc[ai][bj][m][1]); }
    }
};

struct Frame {
    LAS unsigned char* lds;
    int tid, lane, wave, vcu, G;
    const float *x, *g1, *w_in, *b_gate, *w_ao, *conv_w, *w_co, *w_o, *g2, *w_up, *fconv_w, *w_dn, *g3; float* out;
    bf16 *WIN, *WCAT, *WO, *WUP, *WDN, *XN, *IQ, *CH, *CC, *AC, *KV, *GG, *IK, *MRG, *XN2, *ACT, *UPR; float *IW, *T1; unsigned* MASK;
};

struct ColId { __device__ __forceinline__ int operator()(int d) const { return d; } };
struct ColWin { __device__ __forceinline__ int operator()(int d) const {
    if (d < 2048) return d;
    if (d < 5632) return d + 72;
    if (d < 5696) return d - 5632 + 2048;
    if (d < 5704) return d - 5696 + 2112;
    return -1; } };
struct ColWup { __device__ __forceinline__ int operator()(int d) const { const int j = d >> 8, i = d & 255; return i < 128 ? 128 * j + i : DFF + 128 * j + (i - 128); } };
template <class CM> __device__ __forceinline__ void transpose_item(const float* W, int Nsrc, bf16* WT, int ldt, int koff, int kb, int db, LAS float* scr, int lane, const CM cm) {
    const int k0 = 64 * kb, d0 = 32 * db; const int sc = cm(d0 + (lane & 31));
#pragma unroll 8
    for (int i = 0; i < 32; ++i) { const int kk = 2 * i + (lane >> 5); scr[kk * 33 + (lane & 31)] = sc >= 0 ? W[(size_t)(k0 + kk) * Nsrc + sc] : 0.f; }
    LDS_WAIT(); asm volatile("" ::: "memory");
    const int c = lane & 7;
#pragma unroll
    for (int j = 0; j < 4; ++j) { const int n = (lane >> 3) + 8 * j; const LAS float* s = scr + (8 * c) * 33 + n;
        v4u o; o.x = pk2(s[0 * 33], s[1 * 33]); o.y = pk2(s[2 * 33], s[3 * 33]); o.z = pk2(s[4 * 33], s[5 * 33]); o.w = pk2(s[6 * 33], s[7 * 33]);
        *(GAS v4u*)(WT + (size_t)(d0 + n) * ldt + koff + k0 + 8 * c) = o; }
    LDS_WAIT(); asm volatile("" ::: "memory");
}
__device__ __forceinline__ void rms_row_to_bf16(const float* xrow, const float* g, bf16* orow, int lane) {
    const GAS f32x4* xr = (const GAS f32x4*)xrow + lane; const GAS f32x4* gr = (const GAS f32x4*)g + lane;
    f32x4 v[4]; float s = 0.f;
#pragma unroll
    for (int j = 0; j < 4; ++j) { v[j] = xr[64 * j]; s += (v[j].x * v[j].x + v[j].y * v[j].y) + (v[j].z * v[j].z + v[j].w * v[j].w); }
    const float rstd = 1.0f / sqrtf(wave_sum(s) * (1.0f / DM) + EPS);
    GAS unsigned long long* o8 = (GAS unsigned long long*)orow + lane;
#pragma unroll
    for (int j = 0; j < 4; ++j) { const f32x4 gv = gr[64 * j]; o8[64 * j] = (unsigned long long)pk2(v[j].x * rstd * gv.x, v[j].y * rstd * gv.y) | ((unsigned long long)pk2(v[j].z * rstd * gv.z, v[j].w * rstd * gv.w) << 32); }
}
__device__ __forceinline__ void rms_row_to_f32(const float* xrow, const float* g, float* orow, int lane) {
    const GAS f32x4* xr = (const GAS f32x4*)xrow + lane; const GAS f32x4* gr = (const GAS f32x4*)g + lane;
    f32x4 v[4]; float s = 0.f;
#pragma unroll
    for (int j = 0; j < 4; ++j) { v[j] = xr[64 * j]; s += (v[j].x * v[j].x + v[j].y * v[j].y) + (v[j].z * v[j].z + v[j].w * v[j].w); }
    const float rstd = 1.0f / sqrtf(wave_sum(s) * (1.0f / DM) + EPS);
    GAS f32x4* o4 = (GAS f32x4*)orow + lane;
#pragma unroll
    for (int j = 0; j < 4; ++j) { const f32x4 gv = gr[64 * j]; o4[64 * j] = v[j] * rstd * gv; }
}
__device__ __forceinline__ void p0_prologue(Frame& F) {
    LAS float* scr = (LAS float*)(F.lds + RING_OFF + F.wave * 16384);
    const int gw = F.vcu * NWAVES + F.wave, NGW = F.G * NWAVES;
    constexpr int I_IN = 16 * (NP1 / 32), I_AO = 8 * 32, I_CO = 8 * 32, I_O = 16 * 32, I_UP = 16 * (2 * DFF / 32), I_DN = (DFF / 64) * 32;
    constexpr int NITEMS = I_IN + I_AO + I_CO + I_O + I_UP + I_DN;
    for (int it = gw; it < NITEMS; it += NGW) {
        int r = it;
        if (r < I_IN) { transpose_item(F.w_in, IN_COLS, F.WIN, 1024, 0, r / (NP1 / 32), r % (NP1 / 32), scr, F.lane, ColWin()); continue; } r -= I_IN;
        if (r < I_AO) { transpose_item(F.w_ao, 1024, F.WCAT, 1024, 0, r / 32, r % 32, scr, F.lane, ColId()); continue; } r -= I_AO;
        if (r < I_CO) { transpose_item(F.w_co, 1024, F.WCAT, 1024, 512, r / 32, r % 32, scr, F.lane, ColId()); continue; } r -= I_CO;
        if (r < I_O) { transpose_item(F.w_o, 1024, F.WO, 1024, 0, r / 32, r % 32, scr, F.lane, ColId()); continue; } r -= I_O;
        if (r < I_UP) { transpose_item(F.w_up, 2 * DFF, F.WUP, 1024, 0, r / (2 * DFF / 32), r % (2 * DFF / 32), scr, F.lane, ColWup()); continue; } r -= I_UP;
        transpose_item(F.w_dn, 1024, F.WDN, DFF, 0, r / 32, r % 32, scr, F.lane, ColId());
    }
    for (int m = gw; m < M; m += NGW) rms_row_to_bf16(F.x + (size_t)m * DM, F.g1, F.XN + (size_t)m * DM, F.lane);
}

__device__ __forceinline__ unsigned compact_nib(unsigned long long x) {
    x &= 0x0F0F0F0F0F0F0F0FULL; x = (x | (x >> 4)) & 0x00FF00FF00FF00FFULL; x = (x | (x >> 8)) & 0x0000FFFF0000FFFFULL; x = (x | (x >> 16)) & 0x00000000FFFFFFFFULL; return (unsigned)x;
}
__device__ __forceinline__ void select_row_emit(const LAS float* srow, LAS unsigned* hist, int q, int lane, unsigned* maskq) {
    unsigned key[32];
#pragma unroll
    for (int j = 0; j < 32; ++j) { const int idx = 64 * j + lane; const unsigned u = __builtin_bit_cast(unsigned, srow[idx]); const unsigned k = u ^ ((u >> 31) ? 0xffffffffu : 0x80000000u); key[j] = (idx <= q) ? k : 0u; }
    unsigned T = 1u, need = 0u, cnteq = 0u;
    const bool all = (q < TOPK);
    if (!all) {
        unsigned prefix = 0u, kth = TOPK;
#pragma unroll
        for (int pass = 0; pass < 4; ++pass) {
            const int shift = 24 - 8 * pass;
            *(LAS v4u*)(hist + 4 * lane) = (v4u){0u, 0u, 0u, 0u};
            LDS_WAIT();
#pragma unroll
            for (int j = 0; j < 32; ++j) {
                const unsigned hiw = (pass == 0) ? 0u : (key[j] >> ((shift + 8) & 31));
                if (hiw == prefix) __hip_atomic_fetch_add(hist + ((key[j] >> shift) & 255u), 1u, __ATOMIC_RELAXED, __HIP_MEMORY_SCOPE_WORKGROUP);
            }
            LDS_WAIT();
            const v4u c = *(const LAS v4u*)(hist + 4 * lane);
            const unsigned s = c.x + c.y + c.z + c.w;
            unsigned S = s;
#pragma unroll
            for (int o = 1; o < 64; o <<= 1) { const unsigned t = __shfl_down(S, o); if (lane + o < 64) S += t; }
            const unsigned above = S - s;
            const bool mine = (above < kth) && (kth <= S);
            unsigned mybin = 0u, mykth = 0u, mycnt = 0u;
            { unsigned cum = above; bool found = false;
              if (cum + c.w >= kth) { mybin = 4 * lane + 3; mykth = kth - cum; mycnt = c.w; found = true; } else cum += c.w;
              if (!found) { if (cum + c.z >= kth) { mybin = 4 * lane + 2; mykth = kth - cum; mycnt = c.z; found = true; } else cum += c.z; }
              if (!found) { if (cum + c.y >= kth) { mybin = 4 * lane + 1; mykth = kth - cum; mycnt = c.y; found = true; } else cum += c.y; }
              if (!found) { mybin = 4 * lane; mykth = kth - cum; mycnt = c.x; } }
            const unsigned long long bal = __ballot(mine);
            const int src = __ffsll((long long)bal) - 1;
            const unsigned bin = __shfl(mybin, src); kth = __shfl(mykth, src); cnteq = __shfl(mycnt, src);
            prefix = (prefix << 8) | bin;
        }
        T = prefix; need = kth;
    }
    const bool ties = (!all) && (cnteq > need);
    unsigned mw0 = 0u, mw1 = 0u, taken = 0u;
#pragma unroll
    for (int j = 0; j < 32; ++j) {
        bool sel;
        if (!ties) sel = key[j] >= T;
        else { const bool eq = key[j] == T; const unsigned long long be = __ballot(eq);
               const unsigned rank = taken + __builtin_amdgcn_mbcnt_hi((unsigned)(be >> 32), __builtin_amdgcn_mbcnt_lo((unsigned)be, 0u));
               sel = key[j] > T || (eq && rank < need); taken += (unsigned)__builtin_popcountll(be); }
        const unsigned long long m64 = __ballot(sel);
        const unsigned w0 = compact_nib(m64), w1 = compact_nib(m64 >> 4);
        if (lane == j) { mw0 = w0; mw1 = w1; }
    }
    if (lane < 32) *(v2u*)(maskq + (size_t)lane * (SEQ * 2)) = (v2u){mw0, mw1};
}
__device__ __forceinline__ void naive_scores_row(const Frame& F, int b, int q, LAS float* srow, LAS float* iqf, int lane) {
    { const v4u w = *(const v4u*)(F.IQ + (size_t)(b * SEQ + q) * 512 + lane * 8); LAS float* d = iqf + lane * 8;
      d[0] = bflo(w.x); d[1] = bfhi(w.x); d[2] = bflo(w.y); d[3] = bfhi(w.y); d[4] = bflo(w.z); d[5] = bfhi(w.z); d[6] = bflo(w.w); d[7] = bfhi(w.w); }
    float iw[8];
#pragma unroll
    for (int h = 0; h < 8; ++h) iw[h] = F.IW[(size_t)(b * SEQ + q) * 8 + h];
    LDS_WAIT(); asm volatile("" ::: "memory");
    const int nj = (q >> 6) + 1;
    for (int j = 0; j < nj; ++j) {
        const int k = 64 * j + lane;
        const v4u* kp = (const v4u*)(F.IK + (size_t)(b * SEQ + k) * 64);
        float kf[64];
#pragma unroll
        for (int c = 0; c < 8; ++c) { const v4u w = kp[c]; kf[8 * c + 0] = bflo(w.x); kf[8 * c + 1] = bfhi(w.x); kf[8 * c + 2] = bflo(w.y); kf[8 * c + 3] = bfhi(w.y); kf[8 * c + 4] = bflo(w.z); kf[8 * c + 5] = bfhi(w.z); kf[8 * c + 6] = bflo(w.w); kf[8 * c + 7] = bfhi(w.w); }
        float sc = 0.f;
#pragma unroll
        for (int h = 0; h < 8; ++h) { float d = 0.f;
#pragma unroll
            for (int dd = 0; dd < 64; ++dd) d = fmaf(iqf[h * 64 + dd], kf[dd], d);
            sc = fmaf(fmaxf(d, 0.f), iw[h], sc); }
        srow[k] = sc;
    }
    LDS_WAIT(); asm volatile("" ::: "memory");
}
__device__ __forceinline__ void p2_index_select_naive(Frame& F) {
    const int gw = F.vcu * NWAVES + F.wave, NGW = F.G * NWAVES;
    LAS float* srow = (LAS float*)(F.lds + F.wave * 8192);
    LAS unsigned* hist = (LAS unsigned*)(F.lds + 65536 + F.wave * 1024);
    LAS float* iqf = (LAS float*)(F.lds + 73728 + F.wave * 2048);
    for (int r = gw; r < M; r += NGW) {
        const int b = r / SEQ, qq = r % SEQ, q = (b & 1) ? (SEQ - 1 - qq) : qq;
        naive_scores_row(F, b, q, srow, iqf, F.lane);
        select_row_emit(srow, hist, q, F.lane, F.MASK + ((size_t)(b * NTILE) * SEQ + q) * 2);
    }
}
__device__ __forceinline__ void p2_conv_mixer(Frame& F) {
    const int gt = F.vcu * (NWAVES * 64) + F.tid, NT_ = F.G * NWAVES * 64;
    for (int it = gt; it < M * 64; it += NT_) {
        const int t = it >> 6, c0 = (it & 63) * 8, s = t & (SEQ - 1);
        float a[8];
#pragma unroll
        for (int e = 0; e < 8; ++e) a[e] = 0.f;
#pragma unroll
        for (int j = 0; j < 3; ++j) {
            if (s - 2 + j >= 0) {
                f32x4 h0, h1, c0v, c1v; unpack8(*(const v4u*)(F.CH + (size_t)(t - 2 + j) * 512 + c0), h0, h1); unpack8(*(const v4u*)(F.CC + (size_t)(t - 2 + j) * 512 + c0), c0v, c1v);
                const f32x4 w0 = *(const f32x4*)(F.conv_w + j * 512 + c0), w1 = *(const f32x4*)(F.conv_w + j * 512 + c0 + 4);
#pragma unroll
                for (int e = 0; e < 4; ++e) { a[e] = fmaf(w0[e], h0[e] * c0v[e], a[e]); a[4 + e] = fmaf(w1[e], h1[e] * c1v[e], a[4 + e]); }
            }
        }
        bf16* p = F.AC + (size_t)t * 1024 + 512 + c0; f32x4 b0, b1; unpack8(*(const v4u*)p, b0, b1);
        v4u o; o.x = pk2(b0[0] * a[0], b0[1] * a[1]); o.y = pk2(b0[2] * a[2], b0[3] * a[3]); o.z = pk2(b1[0] * a[4], b1[1] * a[5]); o.w = pk2(b1[2] * a[6], b1[3] * a[7]);
        *(v4u*)p = o;
    }
}
__device__ __forceinline__ void p3_attention_naive(Frame& F) {
    const int gw = F.vcu * NWAVES + F.wave, NGW = F.G * NWAVES, lane = F.lane;
    const int hi = (lane >> 2) & 1, eb = 16 * (lane >> 5) + 4 * ((lane >> 3) & 3) + (lane & 3);
    LAS float* slog = (LAS float*)(F.lds + F.wave * 8192);
    for (int r = gw; r < M; r += NGW) {
        const int b = r / SEQ, qq = r % SEQ, q = (b & 1) ? (SEQ - 1 - qq) : qq;
        const int nj = (q >> 6) + 1;
        const unsigned* maskq = F.MASK + ((size_t)(b * NTILE) * SEQ + q) * 2;
        unsigned selbits = 0u;
        for (int j = 0; j < nj; ++j) { const unsigned w = maskq[(size_t)j * (SEQ * 2) + hi]; selbits |= ((w >> eb) & 1u) << j; }
        bf16* qrow = F.AC + (size_t)(b * SEQ + q) * 1024;
        for (int h = 0; h < NH; ++h) {
            float qf[64];
#pragma unroll
            for (int c = 0; c < 8; ++c) { const v4u w = *(const v4u*)(qrow + h * 64 + c * 8); qf[8 * c + 0] = bflo(w.x); qf[8 * c + 1] = bfhi(w.x); qf[8 * c + 2] = bflo(w.y); qf[8 * c + 3] = bfhi(w.y); qf[8 * c + 4] = bflo(w.z); qf[8 * c + 5] = bfhi(w.z); qf[8 * c + 6] = bflo(w.w); qf[8 * c + 7] = bfhi(w.w); }
            float mx = -INFINITY;
            for (int j = 0; j < nj; ++j) {
                const v4u* kp = (const v4u*)(F.KV + (size_t)(b * SEQ + 64 * j + lane) * 1024 + h * 64); float d = 0.f;
#pragma unroll
                for (int c = 0; c < 8; ++c) { const v4u w = kp[c]; d = fmaf(qf[8 * c + 0], bflo(w.x), d); d = fmaf(qf[8 * c + 1], bfhi(w.x), d); d = fmaf(qf[8 * c + 2], bflo(w.y), d); d = fmaf(qf[8 * c + 3], bfhi(w.y), d);
                    d = fmaf(qf[8 * c + 4], bflo(w.z), d); d = fmaf(qf[8 * c + 5], bfhi(w.z), d); d = fmaf(qf[8 * c + 6], bflo(w.w), d); d = fmaf(qf[8 * c + 7], bfhi(w.w), d); }
                const float l = ((selbits >> j) & 1u) ? d : -INFINITY;
                slog[64 * j + lane] = l; mx = fmaxf(mx, l);
            }
            mx = wave_max(mx);
            float sum = 0.f;
            for (int j = 0; j < nj; ++j) { const float l = slog[64 * j + lane]; const float p = (l == -INFINITY) ? 0.f : __builtin_amdgcn_exp2f(l - mx); slog[64 * j + lane] = p; sum += p; }
            sum = wave_sum(sum);
            LDS_WAIT(); asm volatile("" ::: "memory");
            float o = 0.f;
            const bf16* vp = F.KV + (size_t)(b * SEQ) * 1024 + 512 + h * 64 + lane;
            for (int k = 0; k < 64 * nj; ++k) { const float pk = slog[k]; if (__builtin_amdgcn_readfirstlane(__builtin_bit_cast(int, pk)) != 0) o = fmaf(pk, bf2f(vp[(size_t)k * 1024]), o); }
            qrow[h * 64 + lane] = (bf16)f2bf(o / sum);
            LDS_WAIT(); asm volatile("" ::: "memory");
        }
    }
}
__device__ __forceinline__ void p_rows_norm_bf16(Frame& F, const float* src, const float* g, bf16* dst) {
    const int gw = F.vcu * NWAVES + F.wave, NGW = F.G * NWAVES;
    for (int m = gw; m < M; m += NGW) rms_row_to_bf16(src + (size_t)m * DM, g, dst + (size_t)m * DM, F.lane);
}
__device__ __forceinline__ void p_rows_norm_f32(Frame& F, float* io, const float* g) {
    const int gw = F.vcu * NWAVES + F.wave, NGW = F.G * NWAVES;
    for (int m = gw; m < M; m += NGW) rms_row_to_f32(io + (size_t)m * DM, g, io + (size_t)m * DM, F.lane);
}
__device__ __forceinline__ void p_act_chunk(Frame& F, int chunk) {
    const int gt = F.vcu * (NWAVES * 64) + F.tid, NT_ = F.G * NWAVES * 64;
    constexpr int FPR = DFF / 8;
    for (int it = gt; it < (M / 2) * FPR; it += NT_) {
        const int tl = it / FPR, f0 = (it % FPR) * 8, t = chunk * (M / 2) + tl, s = t & (SEQ - 1);
        const int colg = 256 * (f0 >> 7) + (f0 & 127);
        float ag[8], av[8];
#pragma unroll
        for (int e = 0; e < 8; ++e) { ag[e] = 0.f; av[e] = 0.f; }
#pragma unroll
        for (int j = 0; j < 3; ++j) {
            if (s - 2 + j >= 0) {
                const bf16* rp = F.UPR + (size_t)(tl - 2 + j) * (2 * DFF) + colg;
                f32x4 g0, g1, v0, v1; unpack8(*(const v4u*)rp, g0, g1); unpack8(*(const v4u*)(rp + 128), v0, v1);
                const float* wg = F.fconv_w + (size_t)j * (2 * DFF) + f0; const float* wv = wg + DFF;
                const f32x4 wg0 = *(const f32x4*)wg, wg1 = *(const f32x4*)(wg + 4), wv0 = *(const f32x4*)wv, wv1 = *(const f32x4*)(wv + 4);
#pragma unroll
                for (int e = 0; e < 4; ++e) { ag[e] = fmaf(wg0[e], g0[e], ag[e]); ag[4 + e] = fmaf(wg1[e], g1[e], ag[4 + e]); av[e] = fmaf(wv0[e], v0[e], av[e]); av[4 + e] = fmaf(wv1[e], v1[e], av[4 + e]); }
            }
        }
        float r[8];
#pragma unroll
        for (int e = 0; e < 8; ++e) r[e] = ag[e] * sigmoidf_(ag[e]) * av[e];
        v4u o; o.x = pk2(r[0], r[1]); o.y = pk2(r[2], r[3]); o.z = pk2(r[4], r[5]); o.w = pk2(r[6], r[7]);
        *(v4u*)(F.ACT + (size_t)t * DFF + f0) = o;
    }
}

struct Args { const float* in[13]; float* out; unsigned char* ws; int ph_lo, ph_hi; };
constexpr int N_PHASES = 13;
__global__ void __launch_bounds__(NWAVES * 64, 2) fwd_kernel(Args args) {
    extern __shared__ __attribute__((aligned(16))) unsigned char lds[];
    Frame F;
    F.lds = (LAS unsigned char*)lds;
    volatile LAS unsigned* MISC = (volatile LAS unsigned*)(F.lds + MISC_OFF);
    F.tid = threadIdx.x; F.lane = F.tid & 63; F.wave = __builtin_amdgcn_readfirstlane(F.tid >> 6);
    F.G = gridDim.x; { const int bx = blockIdx.x; F.vcu = (F.G % 8 == 0) ? (bx % 8) * (F.G / 8) + bx / 8 : bx; }
    unsigned char* ws = args.ws;
    gu32* ctl = (gu32*)(ws + WS_CTL);
    F.x = args.in[0]; F.g1 = args.in[1]; F.w_in = args.in[2]; F.b_gate = args.in[3]; F.w_ao = args.in[4]; F.conv_w = args.in[5]; F.w_co = args.in[6]; F.w_o = args.in[7];
    F.g2 = args.in[8]; F.w_up = args.in[9]; F.fconv_w = args.in[10]; F.w_dn = args.in[11]; F.g3 = args.in[12]; F.out = args.out;
    F.WIN = (bf16*)(ws + WS_WIN); F.WCAT = (bf16*)(ws + WS_WCAT); F.WO = (bf16*)(ws + WS_WO); F.WUP = (bf16*)(ws + WS_WUP); F.WDN = (bf16*)(ws + WS_WDN);
    F.XN = (bf16*)(ws + WS_XN); F.IQ = (bf16*)(ws + WS_IQ); F.CH = (bf16*)(ws + WS_CH); F.CC = (bf16*)(ws + WS_CC); F.AC = (bf16*)(ws + WS_AC); F.KV = (bf16*)(ws + WS_KV);
    F.GG = (bf16*)(ws + WS_G); F.IK = (bf16*)(ws + WS_IK); F.IW = (float*)(ws + WS_IW); F.MASK = (unsigned*)(ws + WS_MASK);
    F.T1 = (float*)(ws + WS_T1); F.MRG = (bf16*)(ws + WS_MRG); F.XN2 = (bf16*)(ws + WS_XN2); F.ACT = (bf16*)(ws + WS_ACT); F.UPR = (bf16*)(ws + WS_UPR);
    for (int u = F.tid; u < (LDS_BYTES - LDSCTL_OFF) / 4; u += NWAVES * 64) ((LAS unsigned*)(F.lds + LDSCTL_OFF))[u] = 0u;
    __syncthreads();
    XcdBarrier bar = xcd_barrier_post((unsigned*)(ctl + CW_BAR), MISC + 8);
    const int lo = args.ph_lo, hi = args.ph_hi;
#define IN(k) (lo <= (k) && (k) < hi)
#define SEAM(k) do { if (IN(k) && IN((k) + 1)) xcd_barrier(bar); } while (0)

    if (IN(0)) { p0_prologue(F); } SEAM(0);
    if (IN(1)) {
        pg8::Gemm g{F.XN, F.WIN, M, NP1, 1024, 1024, 1024}; pg8::StaticOrder S; S.init(M, NP1, F.G, (int)blockIdx.x);
        EpiProj E{F.AC, F.KV, F.IQ, F.CH, F.CC, F.GG, F.IK, F.IW, F.b_gate};
        pg8::gemm_phase<EpiProj, pg8::StaticOrder, true, true>(F.lds + RING_OFF, g, S, E);
    } SEAM(1);
    if (IN(2)) { p2_index_select_naive(F); p2_conv_mixer(F); } SEAM(2);
    if (IN(3)) { p3_attention_naive(F); } SEAM(3);
    if (IN(4)) {
        { pg8::Gemm g{F.AC, F.WCAT, M, 1024, 512, 1024, 1024}; pg8::StaticOrder S; S.init(M, 1024, F.G, (int)blockIdx.x);
          EpiGateA E{F.T1, F.GG}; pg8::gemm_phase<EpiGateA, pg8::StaticOrder, false, true>(F.lds + RING_OFF, g, S, E); }
        VM_WAIT(); __syncthreads();
        { pg8::Gemm g{F.AC + 512, F.WCAT + 512, M, 1024, 512, 1024, 1024}; pg8::StaticOrder S; S.init(M, 1024, F.G, (int)blockIdx.x);
          EpiGateC E{F.T1, F.GG, F.MRG}; pg8::gemm_phase<EpiGateC, pg8::StaticOrder, false, true>(F.lds + RING_OFF, g, S, E); }
    } SEAM(4);
    if (IN(5)) {
        pg8::Gemm g{F.MRG, F.WO, M, 1024, 1024, 1024, 1024}; pg8::StaticOrder S; S.init(M, 1024, F.G, (int)blockIdx.x);
        EpiResid E{F.x, F.out}; pg8::gemm_phase<EpiResid, pg8::StaticOrder, false, true>(F.lds + RING_OFF, g, S, E);
    } SEAM(5);
    if (IN(6)) { p_rows_norm_bf16(F, F.out, F.g2, F.XN2); } SEAM(6);
    for (int chunk = 0; chunk < 2; ++chunk) {
        if (IN(7 + 2 * chunk)) {
            pg8::Gemm g{F.XN2 + (size_t)chunk * (M / 2) * 1024, F.WUP, M / 2, 2 * DFF, 1024, 1024, 1024}; pg8::StaticOrder S; S.init(M / 2, 2 * DFF, F.G, (int)blockIdx.x);
            EpiRawBf16 E{F.UPR, 2 * DFF}; pg8::gemm_phase<EpiRawBf16, pg8::StaticOrder, true, true>(F.lds + RING_OFF, g, S, E);
        } SEAM(7 + 2 * chunk);
        if (IN(8 + 2 * chunk)) { p_act_chunk(F, chunk); } SEAM(8 + 2 * chunk);
    }
    if (IN(11)) {
        pg8::Gemm g{F.ACT, F.WDN, M, 1024, DFF, DFF, DFF}; pg8::StaticOrder S; S.init(M, 1024, F.G, (int)blockIdx.x);
        EpiResid E{F.out, F.out}; pg8::gemm_phase<EpiResid, pg8::StaticOrder, false, true>(F.lds + RING_OFF, g, S, E);
    } SEAM(11);
    if (IN(12)) { p_rows_norm_f32(F, F.out, F.g3); }
#undef IN
#undef SEAM
}

#ifndef MK_N_LAUNCHES
#define MK_N_LAUNCHES 1
#endif
extern "C" void kernel_launch(void* const* d_in, const int* in_sizes, int n_in, void* d_out, int out_size, void* d_ws, size_t ws_size, hipStream_t stream) {
    static int grid = 0;
    if (grid == 0) {
        if (n_in != 13 || in_sizes[0] != M * DM || out_size != M * DM || ws_size < WS_END) { fprintf(stderr, "kernel_launch: unexpected shapes (n_in %d, in0 %d, out %d, ws %zu); nothing launched\n", n_in, n_in > 0 ? in_sizes[0] : -1, out_size, ws_size); grid = -1; return; }
        int dev = 0, cus = 0, per_cu = 0;
        if (hipGetDevice(&dev) != hipSuccess || hipDeviceGetAttribute(&cus, hipDeviceAttributeMultiprocessorCount, dev) != hipSuccess) { grid = -1; return; }
        if (hipFuncSetAttribute((const void*)fwd_kernel, hipFuncAttributeMaxDynamicSharedMemorySize, LDS_BYTES) != hipSuccess) { fprintf(stderr, "kernel_launch: hipFuncSetAttribute failed\n"); grid = -1; return; }
        if (hipOccupancyMaxActiveBlocksPerMultiprocessor(&per_cu, (const void*)fwd_kernel, NWAVES * 64, LDS_BYTES) != hipSuccess || per_cu < 1) { fprintf(stderr, "kernel_launch: occupancy query reports %d\n", per_cu); per_cu = 1; }
        (void)hipGetLastError();
        grid = cus;
    }
    if (grid < 0) return;
    (void)hipMemsetAsync((char*)d_ws + WS_CTL, 0, CTL_ZERO_BYTES, stream);
    Args a{};
    for (int i = 0; i < 13; ++i) a.in[i] = (const float*)d_in[i];
    a.out = (float*)d_out; a.ws = (unsigned char*)d_ws;
#if MK_N_LAUNCHES == 1
    a.ph_lo = 0; a.ph_hi = N_PHASES;
    hipLaunchKernelGGL(fwd_kernel, dim3(grid), dim3(NWAVES * 64), LDS_BYTES, stream, a);
#else
    for (int p = 0; p < N_PHASES; ++p) { a.ph_lo = p; a.ph_hi = p + 1; hipLaunchKernelGGL(fwd_kernel, dim3(grid), dim3(NWAVES * 64), LDS_BYTES, stream, a); }
#endif
}
```

```cpp
#include <hip/hip_runtime.h>
#include <cstdio>
#include <cstdint>
namespace pg8 {
#define PG8_LAS __attribute__((address_space(3)))
typedef unsigned short bf16_t;
typedef short bf16x8 __attribute__((ext_vector_type(8)));
typedef float f32x4 __attribute__((ext_vector_type(4)));
typedef unsigned u32x4 __attribute__((ext_vector_type(4)));
constexpr int BM = 256, BK = 64, HALF = 128, HTB = HALF * BK * 2  , STAGE_BYTES = 8 * HTB, NXCD = 8, WGM = 8;

__host__ __device__ __forceinline__ int lds_byte(int r, int c) { const int st = (r >> 4) * 2 + (c >> 5), rr = r & 15, cc = c & 31, ob = rr * 64 + cc * 2; return st * 1024 + (ob ^ (((ob >> 9) & 1) << 5)); }
__host__ __device__ __forceinline__ void stage_rc(int b, int& R, int& C) { const int st = b / 1024, sb = b % 1024, swz = sb ^ (((sb >> 9) & 1) << 5); R = (st >> 1) * 16 + swz / 64; C = (st & 1) * 32 + (swz % 64) / 2; }
__host__ __device__ __forceinline__ int perm32(int rho) { const int n = rho >> 4, i = rho & 15; return 8 * (i >> 2) + 4 * n + (i & 3); }

struct Unit { int pm, pn; };
struct Gemm { const bf16_t* A; const bf16_t* Bt; int M, N, K, lda, ldb; };

struct StaticOrder {
    int nM, nN, nwg, G, c;
    __host__ __device__ void init(int M, int N, int G_, int c_) { nM = M / BM; nN = N / BM; nwg = nM * nN; G = G_; c = c_; }
    __host__ __device__ bool next(int i, Unit& u) const {
        const long L = (long)i * G + c; if (L >= nwg) return false;
        int wgid = (int)L; { const int q = nwg / NXCD, r = nwg % NXCD, xcd = wgid % NXCD, off = wgid / NXCD; wgid = (xcd < r ? xcd * (q + 1) : r * (q + 1) + (xcd - r) * q) + off; }
        const int nig = WGM * nN, gid = wgid / nig, fm = gid * WGM, gsz = (nM - fm) < WGM ? (nM - fm) : WGM;
        u.pm = fm + ((wgid % nig) % gsz); u.pn = (wgid % nig) / gsz; return true;
    }
    __device__ __forceinline__ void a_ready(const Unit&) const {}
    __device__ __forceinline__ void done(const Unit&) const {}
};

__device__ __forceinline__ unsigned cvt_pk_bf16(float lo, float hi) { unsigned r; asm volatile("v_cvt_pk_bf16_f32 %0, %1, %2" : "=v"(r) : "v"(lo), "v"(hi)); return r; }
template <class Epi, class Sched, bool ALIGN_EPI = false, bool SP2 = false>
__device__ __forceinline__ void gemm_phase(PG8_LAS unsigned char* lds, const Gemm g, const Sched& S, const Epi& E) {
    const int tid = threadIdx.x, wid = __builtin_amdgcn_readfirstlane(tid >> 6), lane = tid & 63, wr = wid >> 2, wc = wid & 3, fr = lane & 15, fq = lane >> 4;
    const int K = g.K, nt = K / BK;
    unsigned voffA[2], voffB[2];
#pragma unroll
    for (int i = 0; i < 2; ++i) { int R, C; stage_rc(tid * 16 + i * 8192, R, C); const int Rb = Epi::PERM ? ((R & ~31) + perm32(R & 31)) : R;
        voffA[i] = (unsigned)(R * g.lda + C) * 2u; voffB[i] = (unsigned)(Rb * g.ldb + C) * 2u; }
    const size_t kstep = (size_t)(BK * 2);
    const size_t hstepA = (size_t)HALF * g.lda * 2, hstepB = (size_t)HALF * g.ldb * 2;
    const size_t tstepA = 2 * hstepA, tstepB = 2 * hstepB;
    const unsigned ldsw = (unsigned)wid * 1024u;
    const int aoff = lds_byte(wr * 64 + fr, fq * 8), boff = lds_byte(wc * 32 + fr, fq * 8);
#define PG8_SA(b, h) (((b) * 2 + (h)) * HTB)
#define PG8_SB(b, h) ((4 + (b) * 2 + (h)) * HTB)
#define PG8_STAGE(bufoff, gbase, voff) do { _Pragma("unroll") for (int _i = 0; _i < 2; ++_i) \
        __builtin_amdgcn_global_load_lds((const unsigned*)((const char*)(gbase) + (voff)[_i]), (PG8_LAS unsigned*)(lds + (bufoff) + ldsw + _i * 8192), 16, 0, 0); } while (0)
#define PG8_LDA(dst, b, h) do { _Pragma("unroll") for (int m = 0; m < 4; ++m) _Pragma("unroll") for (int k = 0; k < 2; ++k) dst[m][k] = *(const PG8_LAS bf16x8*)(lds + PG8_SA(b, h) + aoff + m * 2048 + k * 1024); } while (0)
#define PG8_LDB(dst, b, h) do { _Pragma("unroll") for (int n = 0; n < 2; ++n) _Pragma("unroll") for (int k = 0; k < 2; ++k) dst[n][k] = *(const PG8_LAS bf16x8*)(lds + PG8_SB(b, h) + boff + n * 2048 + k * 1024); } while (0)
#define PG8_MMA(ai, bj, At, Bt) do { __builtin_amdgcn_s_setprio(1); _Pragma("unroll") for (int m = 0; m < 4; ++m) _Pragma("unroll") for (int n = 0; n < 2; ++n) _Pragma("unroll") for (int k = 0; k < 2; ++k) \
        acc[ai][bj][m][n] = __builtin_amdgcn_mfma_f32_16x16x32_bf16(Bt[n][k], At[m][k], acc[ai][bj][m][n], 0, 0, 0); __builtin_amdgcn_s_setprio(0); } while (0)
#define PG8_WAIT_V(n) asm volatile("s_waitcnt vmcnt(" #n ")" ::: "memory")
#define PG8_WAIT_L(n) asm volatile("s_waitcnt lgkmcnt(" #n ")" ::: "memory")
#define PG8_BAR __builtin_amdgcn_s_barrier()
#define PG8_SCHED __builtin_amdgcn_sched_barrier(0)
    Unit cur, nxt; int ui = 0;
    if (!S.next(0, cur)) return;
    f32x4 acc[2][2][4][2];
#pragma unroll
    for (int a = 0; a < 2; ++a)
#pragma unroll
        for (int b = 0; b < 2; ++b)
#pragma unroll
            for (int m = 0; m < 4; ++m)
#pragma unroll
                for (int n = 0; n < 2; ++n) acc[a][b][m][n] = (f32x4){0.f, 0.f, 0.f, 0.f};
    bf16x8 At[4][2], B0[2][2], B1[2][2];
    const char* cA = (const char*)g.A + (size_t)cur.pm * tstepA; const char* cB = (const char*)g.Bt + (size_t)cur.pn * tstepB;
    S.a_ready(cur);
    if constexpr (SP2) {
        PG8_STAGE(PG8_SB(0, 0), cB, voffB); PG8_STAGE(PG8_SB(0, 1), cB + hstepB, voffB); PG8_STAGE(PG8_SA(0, 0), cA, voffA); PG8_STAGE(PG8_SA(0, 1), cA + hstepA, voffA);
        if (wr == 1) PG8_BAR;
        PG8_WAIT_V(2); PG8_BAR;
        PG8_STAGE(PG8_SB(1, 0), cB + kstep, voffB); PG8_STAGE(PG8_SA(1, 0), cA + kstep, voffA); PG8_STAGE(PG8_SB(1, 1), cB + hstepB + kstep, voffB);
        PG8_WAIT_V(6); PG8_BAR;
    } else {
        PG8_STAGE(PG8_SB(0, 0), cB, voffB); PG8_STAGE(PG8_SA(0, 0), cA, voffA); PG8_STAGE(PG8_SB(0, 1), cB + hstepB, voffB); PG8_STAGE(PG8_SA(0, 1), cA + hstepA, voffA);
        if (wr == 1) PG8_BAR;
        PG8_WAIT_V(4); PG8_BAR;
        PG8_STAGE(PG8_SB(1, 0), cB + kstep, voffB); PG8_STAGE(PG8_SA(1, 0), cA + kstep, voffA); PG8_STAGE(PG8_SB(1, 1), cB + hstepB + kstep, voffB);
        PG8_WAIT_V(6); PG8_BAR;
    }
    for (;;) {
        const bool has_next = S.next(ui + 1, nxt);
        const char* nA = has_next ? (const char*)g.A + (size_t)nxt.pm * tstepA : cA; const char* nB = has_next ? (const char*)g.Bt + (size_t)nxt.pn * tstepB : cB;
        for (int t = 0; t < nt; t += 2) {
            const bool last = (t == nt - 2);
            const char* a1 = cA + (size_t)(t + 1) * kstep;
            const char* a2 = last ? nA : cA + (size_t)(t + 2) * kstep; const char* b2 = last ? nB : cB + (size_t)(t + 2) * kstep;
            const char* a3 = a2 + kstep; const char* b3 = b2 + kstep;
            if (last && has_next) S.a_ready(nxt);
            if constexpr (SP2) {
            PG8_LDB(B0, 0, 0); PG8_LDB(B1, 0, 1); PG8_SCHED; PG8_LDA(At, 0, 0); PG8_STAGE(PG8_SA(1, 1), a1 + hstepA, voffA);
            PG8_WAIT_V(8); PG8_WAIT_L(0); PG8_BAR; PG8_MMA(0, 0, At, B0); PG8_MMA(0, 1, At, B1); PG8_BAR; PG8_SCHED;
            PG8_LDA(At, 0, 1); PG8_STAGE(PG8_SB(0, 0), b2, voffB); PG8_STAGE(PG8_SB(0, 1), b2 + hstepB, voffB); PG8_STAGE(PG8_SA(0, 0), a2, voffA);
            PG8_WAIT_V(8); PG8_WAIT_L(0); PG8_BAR; PG8_MMA(1, 0, At, B0); PG8_MMA(1, 1, At, B1); PG8_BAR; PG8_SCHED;
            PG8_LDB(B0, 1, 0); PG8_LDB(B1, 1, 1); PG8_SCHED; PG8_LDA(At, 1, 0); PG8_STAGE(PG8_SA(0, 1), a2 + hstepA, voffA);
            PG8_WAIT_V(8); PG8_WAIT_L(0); PG8_BAR; PG8_MMA(0, 0, At, B0); PG8_MMA(0, 1, At, B1); PG8_BAR; PG8_SCHED;
            PG8_LDA(At, 1, 1); PG8_STAGE(PG8_SB(1, 0), b3, voffB); PG8_STAGE(PG8_SB(1, 1), b3 + hstepB, voffB); PG8_STAGE(PG8_SA(1, 0), a3, voffA);
            PG8_WAIT_V(8); PG8_WAIT_L(0); PG8_BAR; PG8_MMA(1, 0, At, B0); PG8_MMA(1, 1, At, B1); PG8_BAR; PG8_SCHED;
            } else {
            PG8_LDB(B0, 0, 0); PG8_SCHED; PG8_LDA(At, 0, 0); PG8_STAGE(PG8_SA(1, 1), a1 + hstepA, voffA);
            PG8_WAIT_L(8); PG8_BAR; PG8_WAIT_L(0); PG8_MMA(0, 0, At, B0); PG8_BAR; PG8_SCHED;
            PG8_LDB(B1, 0, 1); PG8_STAGE(PG8_SB(0, 0), b2, voffB);
            PG8_BAR; PG8_WAIT_L(0); PG8_MMA(0, 1, At, B1); PG8_BAR;
            PG8_LDA(At, 0, 1); PG8_STAGE(PG8_SA(0, 0), a2, voffA);
            PG8_BAR; PG8_WAIT_L(0); PG8_MMA(1, 0, At, B0); PG8_BAR; PG8_SCHED;
            PG8_STAGE(PG8_SB(0, 1), b2 + hstepB, voffB);
            PG8_WAIT_V(6); PG8_BAR; PG8_MMA(1, 1, At, B1); PG8_BAR;
            PG8_LDB(B0, 1, 0); PG8_SCHED; PG8_LDA(At, 1, 0); PG8_STAGE(PG8_SA(0, 1), a2 + hstepA, voffA);
            PG8_WAIT_L(8); PG8_BAR; PG8_WAIT_L(0); PG8_MMA(0, 0, At, B0); PG8_BAR; PG8_SCHED;
            PG8_LDB(B1, 1, 1); PG8_STAGE(PG8_SB(1, 0), b3, voffB);
            PG8_BAR; PG8_WAIT_L(0); PG8_MMA(0, 1, At, B1); PG8_BAR;
            PG8_LDA(At, 1, 1); PG8_STAGE(PG8_SA(1, 0), a3, voffA);
            PG8_BAR; PG8_WAIT_L(0); PG8_MMA(1, 0, At, B0); PG8_BAR; PG8_SCHED;
            PG8_STAGE(PG8_SB(1, 1), b3 + hstepB, voffB);
            PG8_WAIT_V(6); PG8_BAR; PG8_MMA(1, 1, At, B1); PG8_BAR;
            }
        }
        if constexpr (ALIGN_EPI) { if (wr == 0) PG8_BAR; }
        if constexpr (!Epi::AFTER_DRAIN) { E(acc, cur, wr, wc, fr, fq); S.done(cur); }
        if (!has_next) break;
#pragma unroll
        for (int a = 0; a < 2; ++a)
#pragma unroll
            for (int b = 0; b < 2; ++b)
#pragma unroll
                for (int m = 0; m < 4; ++m)
#pragma unroll
                    for (int n = 0; n < 2; ++n) acc[a][b][m][n] = (f32x4){0.f, 0.f, 0.f, 0.f};
        cur = nxt; cA = nA; cB = nB; ++ui;
        if constexpr (ALIGN_EPI) { if (wr == 1) PG8_BAR; }
    }
    PG8_WAIT_V(0);
    if constexpr (!ALIGN_EPI) { if (wr == 0) PG8_BAR; }
    PG8_BAR;
    if constexpr (Epi::AFTER_DRAIN) { E.fused(acc, cur, wr, wc, fr, fq, lds, wid, lane); S.done(cur); }
#undef PG8_SA
#undef PG8_SB
#undef PG8_STAGE
#undef PG8_LDA
#undef PG8_LDB
#undef PG8_MMA
#undef PG8_WAIT_V
#undef PG8_WAIT_L
#undef PG8_BAR
#undef PG8_SCHED
}
}
#include <hip/hip_bf16.h>
#include <cmath>
namespace attn_body {
using bf16=__hip_bfloat16;
using bf16x8=__attribute__((ext_vector_type(8)))short;
using s16x4=__attribute__((ext_vector_type(4)))short;
using f32x16=__attribute__((ext_vector_type(16)))float;
using u32x4=__attribute__((ext_vector_type(4)))unsigned;
constexpr int BATCH=8,NHEAD=8,SEQ=2048,D=64,DM=1024;
constexpr int NW=8,QBLK=32,QB=QBLK*NW,KVBLK=64,NQB=SEQ/QB;
constexpr int ATTN_PITCH=DM, ATTN_UNIT_ROWS=QB;
__device__ __forceinline__ int crow(int r,int hi){return (r&3)+8*(r>>2)+4*hi;}
#define SBAR() __builtin_amdgcn_sched_barrier(0)
__device__ __forceinline__ void cmask(f32x16&p0,f32x16&p1,int jb,int qrel,int hi){
  const float NEG=-INFINITY; int kb=64*jb+4*hi;
  #pragma unroll
  for(int r=0;r<16;++r){int kv=kb+(r&3)+8*(r>>2); if(kv>qrel)p0[r]=NEG; if(kv+32>qrel)p1[r]=NEG;}
}

constexpr int NSLOT=3, SLOTB=8192;
constexpr int LDS_K=0, LDS_V=NSLOT*SLOTB, LDS_WS=2*NSLOT*SLOTB, LDS_OST=LDS_WS+NW*64*4, LDS_MSK=LDS_OST+NW*4096, LDS_BYTES=LDS_MSK+65536;
constexpr float C2=0.125f*1.4426950408889634f;
__device__ __forceinline__ void glds16(const void*gsrc,unsigned lds_dst){unsigned keep;
  asm volatile("s_mov_b32 %0, m0\n\ts_mov_b32 m0, %2\n\ts_nop 0\n\tglobal_load_lds_dwordx4 %1, off\n\ts_mov_b32 m0, %0":"=&s"(keep):"v"(gsrc),"s"(lds_dst):"memory");}
__device__ __forceinline__ float max3f(float a,float b,float c){float r;asm("v_max3_f32 %0, %1, %2, %3":"=v"(r):"v"(a),"v"(b),"v"(c));return r;}
__device__ __forceinline__ float max2f(float a,float b){float r;asm("v_max_f32_e32 %0, %1, %2":"=v"(r):"v"(a),"v"(b));return r;}
__device__ __forceinline__ float fadd_s(float a,float b){float r;asm("v_add_f32_e32 %0, %1, %2":"=v"(r):"v"(a),"v"(b));return r;}
__device__ __forceinline__ float fsub_s(float a,float b){float r;asm("v_sub_f32_e32 %0, %1, %2":"=v"(r):"v"(a),"v"(b));return r;}
typedef float f32x2_t __attribute__((ext_vector_type(2))); typedef __bf16 bf16x2_t __attribute__((ext_vector_type(2)));
__device__ __forceinline__ unsigned cvtpk_s(float lo,float hi){f32x2_t v={lo,hi};bf16x2_t b=__builtin_convertvector(v,bf16x2_t);return __builtin_bit_cast(unsigned,b);}
#define WAIT_BAR(N) asm volatile("s_waitcnt vmcnt(" #N ") lgkmcnt(0)\n\ts_barrier":::"memory")

__device__ __forceinline__ void qkt(f32x16&p0,f32x16&p1,const char*Kslot,const bf16x8*qr,const f32x16&negm,int r32,int hi){
  const char*kb=Kslot+hi*1024+r32*16;
  #pragma unroll
  for(int d0=0;d0<4;++d0){
    const bf16x8 b0=*reinterpret_cast<const bf16x8*>(kb+d0*2048);
    const bf16x8 b1=*reinterpret_cast<const bf16x8*>(kb+d0*2048+512);
    if(d0==0){p0=__builtin_amdgcn_mfma_f32_32x32x16_bf16(b0,qr[0],negm,0,0,0);p1=__builtin_amdgcn_mfma_f32_32x32x16_bf16(b1,qr[0],negm,0,0,0);}
    else{p0=__builtin_amdgcn_mfma_f32_32x32x16_bf16(b0,qr[d0],p0,0,0,0);p1=__builtin_amdgcn_mfma_f32_32x32x16_bf16(b1,qr[d0],p1,0,0,0);}}
}
typedef __attribute__((address_space(3))) const char* lds_cptr;
typedef short v4i16_t __attribute__((ext_vector_type(4)));
__device__ __forceinline__ void kload8(bf16x8*kf,lds_cptr kp){
  kf[0]=*(const __attribute__((address_space(3))) bf16x8*)(kp);      kf[1]=*(const __attribute__((address_space(3))) bf16x8*)(kp+512);
  kf[2]=*(const __attribute__((address_space(3))) bf16x8*)(kp+2048); kf[3]=*(const __attribute__((address_space(3))) bf16x8*)(kp+2560);
  kf[4]=*(const __attribute__((address_space(3))) bf16x8*)(kp+4096); kf[5]=*(const __attribute__((address_space(3))) bf16x8*)(kp+4608);
  kf[6]=*(const __attribute__((address_space(3))) bf16x8*)(kp+6144); kf[7]=*(const __attribute__((address_space(3))) bf16x8*)(kp+6656);
}
__device__ __forceinline__ void kload2(bf16x8*kf,lds_cptr kp,int j){ kf[2*j]=*(const __attribute__((address_space(3))) bf16x8*)(kp+j*2048); kf[2*j+1]=*(const __attribute__((address_space(3))) bf16x8*)(kp+j*2048+512); }
__device__ __forceinline__ s16x4 vtr(lds_cptr p){ return __builtin_bit_cast(s16x4,__builtin_amdgcn_ds_read_tr16_b64_v4i16((__attribute__((address_space(3))) v4i16_t*)p)); }
__device__ __forceinline__ float rowmax(const f32x16&p0,const f32x16&p1){
  float a=max3f(p0[0],p0[1],p1[0]),b=max3f(p0[2],p0[3],p1[1]);a=max3f(a,p1[2],p1[3]);
  #pragma unroll
  for(int r=4;r<16;r+=4){a=max3f(a,p0[r],p0[r+1]);b=max3f(b,p0[r+2],p0[r+3]);a=max3f(a,p1[r],p1[r+1]);b=max3f(b,p1[r+2],p1[r+3]);}
  const float m=max2f(a,b);
  auto rr=__builtin_amdgcn_permlane32_swap(__float_as_uint(m),__float_as_uint(m),false,false);
  return max2f(__uint_as_float(rr[0]),__uint_as_float(rr[1]));
}
__device__ __forceinline__ void pv(f32x16*o,int vb,bf16x8 pa0,bf16x8 pa1,bf16x8 pa2,bf16x8 pa3){
  #pragma unroll
  for(int d0=0;d0<2;++d0){s16x4 lo[4],hi[4];
    #pragma unroll
    for(int ks=0;ks<4;++ks){
      asm volatile("ds_read_b64_tr_b16 %0,%1 offset:%c2":"=&v"(lo[ks]):"v"(vb),"i"(d0*4096+ks*1024):"memory");
      asm volatile("ds_read_b64_tr_b16 %0,%1 offset:%c2":"=&v"(hi[ks]):"v"(vb),"i"(d0*4096+ks*1024+512):"memory");}
    asm volatile("s_waitcnt lgkmcnt(0)":::"memory");SBAR();
    #define PK(k) (bf16x8){lo[k][0],lo[k][1],lo[k][2],lo[k][3],hi[k][0],hi[k][1],hi[k][2],hi[k][3]}
    o[d0]=__builtin_amdgcn_mfma_f32_32x32x16_bf16(pa0,PK(0),o[d0],0,0,0);
    o[d0]=__builtin_amdgcn_mfma_f32_32x32x16_bf16(pa1,PK(1),o[d0],0,0,0);
    o[d0]=__builtin_amdgcn_mfma_f32_32x32x16_bf16(pa2,PK(2),o[d0],0,0,0);
    o[d0]=__builtin_amdgcn_mfma_f32_32x32x16_bf16(pa3,PK(3),o[d0],0,0,0);
    #undef PK
  }
}

#ifndef ATTN_STORE16
#define ATTN_STORE16(p,v) (*(u32x4*)(p)=(v))
#endif
template<int THRL> __device__ __forceinline__ void attn_unit(int b,int h,int qb,const bf16*Q,const bf16*__restrict__ K,const bf16*__restrict__ V,bf16*O,const unsigned*MASK,char*shm){
  const int tid=threadIdx.x,lane=tid&63,r32=lane&31,hi=lane>>5; const int wid=__builtin_amdgcn_readfirstlane(tid>>6);
  const long rowbase=(long)b*SEQ; const int q0=qb*QB;
  const bf16*Qw=Q+(rowbase+q0+wid*QBLK)*DM+h*D;
  const bf16*Kh=K+rowbase*DM+h*D,*Vh=V+rowbase*DM+h*D;
  const unsigned lds0=(unsigned)(uintptr_t)shm;
  float*wsf=(float*)(shm+LDS_WS)+wid*64;
  const bf16*ksrc=Kh+(long)lane*DM+wid*8;
  const bf16*vsrc=Vh+(long)(16*(wid&3)+(lane>>2))*DM+(wid>>2)*32+(lane&3)*8;
  const unsigned kdst=lds0+LDS_K+wid*1024, vdst=lds0+LDS_V+wid*1024;
  #define DMA_K(t,slot) glds16(ksrc+(long)(t)*KVBLK*DM,(unsigned)__builtin_amdgcn_readfirstlane(kdst+(slot)))
  #define DMA_V(t,slot) glds16(vsrc+(long)(t)*KVBLK*DM,(unsigned)__builtin_amdgcn_readfirstlane(vdst+(slot)))
  const int vb0=(int)(lds0+LDS_V)+((lane>>4)&1)*32+(lane&3)*8+(4*hi+((lane&15)>>2))*64;
  const char*Kbase=shm+LDS_K; bf16x8 kf[8];
  const lds_cptr shm3=(lds_cptr)shm; const lds_cptr kp0=shm3+LDS_K+hi*1024+r32*16; const lds_cptr vp0=shm3+LDS_V+((lane>>4)&1)*32+(lane&3)*8+(4*hi+((lane&15)>>2))*64;
  const int NT=(q0+QB)/KVBLK;
  typedef __attribute__((address_space(3))) unsigned lds_u32; typedef __attribute__((address_space(3))) u32x4 lds_u32x4;
  { const unsigned*mg=MASK+((size_t)(b*32)*SEQ+q0)*2+(size_t)(tid>>7)*(SEQ*2)+(tid&127)*4; lds_u32x4*ml=(lds_u32x4*)((lds_cptr)shm+LDS_MSK)+tid;
    for(int p=0;p<NT/4;++p){ const u32x4 v=*(const u32x4*)(mg+(size_t)p*(4*SEQ*2)); ml[p*512]=v; }
    asm volatile("s_waitcnt vmcnt(0) lgkmcnt(0)":::"memory"); }
  const lds_u32*mrow=(const lds_u32*)((lds_cptr)shm+LDS_MSK)+(wid*QBLK+r32)*2+hi;
  #define MSK(v,mw,e) __builtin_bit_cast(float,__builtin_bit_cast(unsigned,(v))&(unsigned)__builtin_amdgcn_sbfe((int)(mw),(e),1))
  DMA_K(0,0);DMA_V(0,0);DMA_K(1,SLOTB);
  bf16x8 qr[4];
  #pragma unroll
  for(int d0=0;d0<4;++d0)qr[d0]=*reinterpret_cast<const bf16x8*>(&Qw[(long)r32*DM+d0*16+hi*8]);
  float mhat=0.f,l_reg=0.f;f32x16 o[2];o[0]=f32x16{};o[1]=f32x16{};f32x16 negm=f32x16{};asm volatile("":"+v"(negm));
  const int qrel=wid*QBLK+r32;
  #define CMASK(P0,P1,t) do{}while(0)
  bool resc=false;
  #define START(P0,P1) do{ const float rm=rowmax(P0,P1); resc=false; \
    { const float dl=rm; mhat=fadd_s(mhat,dl); \
      _Pragma("unroll") for(int r=0;r<16;++r){P0[r]=fsub_s(P0[r],dl);P1[r]=fsub_s(P1[r],dl);} \
      _Pragma("unroll") for(int r=0;r<16;++r)negm[r]=-mhat; asm volatile("":"+v"(negm)); } \
    _Pragma("unroll") for(int r=0;r<16;++r)P0[r]=MSK(__builtin_amdgcn_exp2f(P0[r]),mw0_,r); }while(0)
  #define RESC() do{ if(resc){ asm volatile("s_waitcnt lgkmcnt(0)":::"memory"); \
      _Pragma("unroll") for(int d_=0;d_<2;++d_) _Pragma("unroll") for(int r=0;r<16;++r)o[d_][r]*=wsf[crow(r,hi)]; } }while(0)
  f32x16 pA0,pA1,pB0,pB1;
  int sl_prev=0,sl_cur=0,sl_next=SLOTB;
  #define ROT() do{sl_prev=sl_cur;sl_cur=sl_next;sl_next=(sl_next==(NSLOT-1)*SLOTB)?0:sl_next+SLOTB;}while(0)
  DMA_K(2,2*SLOTB);
  WAIT_BAR(3);
  qkt(pA0,pA1,Kbase,qr,negm,r32,hi);asm volatile("s_nop 15\n\ts_nop 7":"+v"(pA0),"+v"(pA1));CMASK(pA0,pA1,0);
  const unsigned mw0_=mrow[0];
  START(pA0,pA1);
  _Pragma("unroll") for(int r=0;r<16;++r)pA1[r]=MSK(__builtin_amdgcn_exp2f(pA1[r]),mw0_,16+r);
  WAIT_BAR(0);
  DMA_K(3,0);DMA_V(1,SLOTB);
  ROT();
  kload8(kf,kp0+sl_cur);
  WAIT_BAR(2);
  s16x4 vlo[8],vhi[8]; u32x4 pw0,pw1,pw2,pw3;
  #define PKW(P,B) cvtpk_s(P[B],P[B+1])
  #define PAF(k) __builtin_bit_cast(bf16x8,pw##k)
  #define VFR(i) (bf16x8){vlo[i][0],vlo[i][1],vlo[i][2],vlo[i][3],vhi[i][0],vhi[i][1],vhi[i][2],vhi[i][3]}
  #define PIN(x) asm volatile("":"+v"(x))
  #define MX3(a,b,c) __builtin_fmaxf(__builtin_fmaxf((a),(b)),(c))
  #define GAPA(MF,A0,A1,A2,A3,W0,W1,PW) do{ MF; sacc+=A0; sacc+=A1; sacc+=A2; sacc+=A3; PIN(sacc); W0; W1; PIN(PW); SBAR(); }while(0)
  #define EX(v) __builtin_amdgcn_exp2f(v)
  #define GAPB(MF,X,B,EO) do{ MF; X[B]=MSK(EX(X[B]),mw_,(EO)+(B)); X[B+1]=MSK(EX(X[B+1]),mw_,(EO)+(B)+1); X[B+2]=MSK(EX(X[B+2]),mw_,(EO)+(B)+2); X[B+3]=MSK(EX(X[B+3]),mw_,(EO)+(B)+3); PIN(X); SBAR(); }while(0)
  #define VRD(i) do{ vlo[i]=vtr(vp_+(((i)>>2)*4096+((i)&3)*1024)); vhi[i]=vtr(vp_+(((i)>>2)*4096+((i)&3)*1024+512)); }while(0)
  #define KRD(G,j) do{ if(G){ kload2(kf,kp0+sl_next,j); SBAR(); } }while(0)
  #define STEP(C0,C1,P0,P1,t,GK,GV,GL) do{ SBAR(); \
    const lds_cptr vp_=vp0+sl_prev; const unsigned mw_=mrow[(t)*512]; \
    VRD(0); SBAR(); float sacc=(P0[0]+P0[1]); \
    GAPA(C0=__builtin_amdgcn_mfma_f32_32x32x16_bf16(kf[0],qr[0],negm,0,0,0), P0[2],P0[3],P0[4],P0[5],     pw0[0]=PKW(P0,0), pw0[1]=PKW(P0,2), pw0); \
    VRD(4); SBAR(); GAPA(C1=__builtin_amdgcn_mfma_f32_32x32x16_bf16(kf[1],qr[0],negm,0,0,0), P0[6],P0[7],P0[8],P0[9],     pw0[2]=PKW(P0,4), pw0[3]=PKW(P0,6), pw0); \
    VRD(1); SBAR(); GAPA(C0=__builtin_amdgcn_mfma_f32_32x32x16_bf16(kf[2],qr[1],C0,0,0,0),   P0[10],P0[11],P0[12],P0[13], pw1[0]=PKW(P0,8), pw1[1]=PKW(P0,10), pw1); \
    VRD(5); SBAR(); GAPA(C1=__builtin_amdgcn_mfma_f32_32x32x16_bf16(kf[3],qr[1],C1,0,0,0),   P0[14],P0[15],P1[0],P1[1],   pw1[2]=PKW(P0,12),pw1[3]=PKW(P0,14), pw1); \
    VRD(2); SBAR(); GAPA(C0=__builtin_amdgcn_mfma_f32_32x32x16_bf16(kf[4],qr[2],C0,0,0,0),   P1[2],P1[3],P1[4],P1[5],     pw2[0]=PKW(P1,0), pw2[1]=PKW(P1,2), pw2); \
    VRD(6); SBAR(); GAPA(C1=__builtin_amdgcn_mfma_f32_32x32x16_bf16(kf[5],qr[2],C1,0,0,0),   P1[6],P1[7],P1[8],P1[9],     pw2[2]=PKW(P1,4), pw2[3]=PKW(P1,6), pw2); \
    VRD(3); SBAR(); GAPA(C0=__builtin_amdgcn_mfma_f32_32x32x16_bf16(kf[6],qr[3],C0,0,0,0),   P1[10],P1[11],P1[12],P1[13], pw3[0]=PKW(P1,8), pw3[1]=PKW(P1,10), pw3); \
    VRD(7); SBAR(); GAPA(C1=__builtin_amdgcn_mfma_f32_32x32x16_bf16(kf[7],qr[3],C1,0,0,0),   P1[14],P1[15],0.f,0.f,       pw3[2]=PKW(P1,12),pw3[3]=PKW(P1,14), pw3); \
    l_reg+=sacc; \
    if(GK){DMA_K((t)+3,sl_cur);} if(GV){DMA_V((t)+1,sl_next);} \
    CMASK(C0,C1,t); \
    { float a=MX3(C0[0],C0[1],C1[0]),b=MX3(C0[2],C0[3],C1[1]); a=MX3(a,C1[2],C1[3]); \
      _Pragma("unroll") for(int r=4;r<16;r+=4){a=MX3(a,C0[r],C0[r+1]);b=MX3(b,C0[r+2],C0[r+3]);a=MX3(a,C1[r],C1[r+1]);b=MX3(b,C1[r+2],C1[r+3]);} \
      float rm=__builtin_fmaxf(a,b); { auto rr=__builtin_amdgcn_permlane32_swap(__float_as_uint(rm),__float_as_uint(rm),false,false); rm=__builtin_fmaxf(__uint_as_float(rr[0]),__uint_as_float(rr[1])); } \
      resc=false; \
      if(__builtin_expect(__any(rm>(float)THRL),0)){ const float dl=__builtin_fmaxf(rm,0.f); mhat+=dl; \
        _Pragma("unroll") for(int r=0;r<16;++r){C0[r]-=dl;C1[r]-=dl;} \
        _Pragma("unroll") for(int r=0;r<16;++r)negm[r]=-mhat; asm volatile("":"+v"(negm)); \
        const float f=__builtin_amdgcn_exp2f(-dl); l_reg*=f; if(hi==0)wsf[r32]=f; resc=true; } } \
    SBAR(); \
    GAPB(o[0]=__builtin_amdgcn_mfma_f32_32x32x16_bf16(PAF(0),VFR(0),o[0],0,0,0), C0,0,0); \
    GAPB(o[1]=__builtin_amdgcn_mfma_f32_32x32x16_bf16(PAF(0),VFR(4),o[1],0,0,0), C0,4,0); \
    KRD(GL,0); GAPB(o[0]=__builtin_amdgcn_mfma_f32_32x32x16_bf16(PAF(1),VFR(1),o[0],0,0,0), C0,8,0); \
    KRD(GL,1); GAPB(o[1]=__builtin_amdgcn_mfma_f32_32x32x16_bf16(PAF(1),VFR(5),o[1],0,0,0), C0,12,0); \
    KRD(GL,2); GAPB(o[0]=__builtin_amdgcn_mfma_f32_32x32x16_bf16(PAF(2),VFR(2),o[0],0,0,0), C1,0,16); \
    KRD(GL,3); GAPB(o[1]=__builtin_amdgcn_mfma_f32_32x32x16_bf16(PAF(2),VFR(6),o[1],0,0,0), C1,4,16); \
    GAPB(o[0]=__builtin_amdgcn_mfma_f32_32x32x16_bf16(PAF(3),VFR(3),o[0],0,0,0), C1,8,16); \
    GAPB(o[1]=__builtin_amdgcn_mfma_f32_32x32x16_bf16(PAF(3),VFR(7),o[1],0,0,0), C1,12,16); \
    }while(0)
  int t=1;
  #undef CMASK
  #define CMASK(P0,P1,t) do{}while(0)
  for(;t+5<NT;t+=2){
    STEP(pB0,pB1,pA0,pA1,t,true,true,true);     WAIT_BAR(2); RESC(); ROT();
    STEP(pA0,pA1,pB0,pB1,t+1,true,true,true);   WAIT_BAR(2); RESC(); ROT();
  }
  #undef CMASK
  #define CMASK(P0,P1,t) do{}while(0)
  #define ENDW(tt) do{ if((tt)+3<NT){WAIT_BAR(2);} else if((tt)+2<NT){WAIT_BAR(1);} else {WAIT_BAR(0);} }while(0)
  for(;t+1<NT;t+=2){
    STEP(pB0,pB1,pA0,pA1,t,(t+3<NT),(t+1<NT),(t+1<NT));       ENDW(t);   RESC(); ROT();
    STEP(pA0,pA1,pB0,pB1,t+1,(t+4<NT),(t+2<NT),(t+2<NT));     ENDW(t+1); RESC(); ROT();
  }
  STEP(pB0,pB1,pA0,pA1,NT-1,false,false,false); RESC();
  { float sacc=pB0[0]+pB0[1]; _Pragma("unroll") for(int r=2;r<16;++r)sacc+=pB0[r]; _Pragma("unroll") for(int r=0;r<16;++r)sacc+=pB1[r]; l_reg+=sacc;
    pw0=(u32x4){PKW(pB0,0),PKW(pB0,2),PKW(pB0,4),PKW(pB0,6)};pw1=(u32x4){PKW(pB0,8),PKW(pB0,10),PKW(pB0,12),PKW(pB0,14)};pw2=(u32x4){PKW(pB1,0),PKW(pB1,2),PKW(pB1,4),PKW(pB1,6)};pw3=(u32x4){PKW(pB1,8),PKW(pB1,10),PKW(pB1,12),PKW(pB1,14)};
    SBAR(); pv(o,vb0+sl_cur,PAF(0),PAF(1),PAF(2),PAF(3)); }
  #undef PKW
  #undef PAF
  #undef VFR
  #undef PIN
  #undef MX3
  #undef GAPA
  #undef GAPB
  #undef EX
  #undef VRD
  #undef KRD
  #undef STEP
  #undef ENDW
  {auto rr=__builtin_amdgcn_permlane32_swap(__float_as_uint(l_reg),__float_as_uint(l_reg),false,false);l_reg=__uint_as_float(rr[0])+__uint_as_float(rr[1]);}
  if(hi==0)wsf[32+r32]=l_reg;asm volatile("s_waitcnt lgkmcnt(0)":::"memory");
  float rli[16];
  #pragma unroll
  for(int r=0;r<16;++r)rli[r]=__builtin_amdgcn_rcpf(wsf[32+crow(r,hi)]);
  bf16*Ow=O+(rowbase+q0+wid*QBLK)*DM+h*D;
  { bf16*stg=(bf16*)(shm+LDS_OST)+wid*2048;
    #pragma unroll
    for(int r=0;r<16;++r){const int orow=crow(r,hi);
      #pragma unroll
      for(int d0=0;d0<2;++d0)stg[orow*64+d0*32+r32]=__float2bfloat16(o[d0][r]*rli[r]);}
    asm volatile("s_waitcnt lgkmcnt(0)":::"memory");
    #pragma unroll
    for(int i=0;i<4;++i){const int row=i*8+(lane>>3),ch=lane&7; const u32x4 v=*(const u32x4*)(stg+row*64+ch*8); ATTN_STORE16(Ow+(long)row*DM+ch*8,v);} }
  asm volatile("s_waitcnt lgkmcnt(0)\n\ts_barrier":::"memory");
  #undef DMA_K
  #undef DMA_V
  #undef CMASK
  #undef START
  #undef RESC
  #undef ROT
  #undef MSK
}
constexpr int ATTN_LDS_BYTES=LDS_BYTES;
struct AttnTensors { const bf16* Q; const bf16* K; const bf16* V; bf16* O; const unsigned* MASK; };
struct AttnUnit { int bh; int qb; };
struct StaticOrder {
  int vcu, G;
  __device__ __forceinline__ explicit StaticOrder(int grid,int block):vcu((grid%8==0)?(block%8)*(grid/8)+block/8:block),G(grid){}
  __device__ __forceinline__ bool next(int i,AttnUnit&u)const{ const int pair=vcu+(i>>1)*G; if(pair>=BATCH*NHEAD*4)return false; const int s=pair&3; u.bh=pair>>2; u.qb=(i&1)?7-s:s; return true; }
  __device__ __forceinline__ void a_ready(const AttnUnit&)const{}
  __device__ __forceinline__ void done(const AttnUnit&)const{}
};
template<class Sched,int THRL=8> __device__ __forceinline__ void attn_phase(char*lds,const AttnTensors&T,const Sched&S){
  AttnUnit u;
  for(int i=0;S.next(i,u);++i){ S.a_ready(u); attn_unit<THRL>(u.bh/NHEAD,u.bh%NHEAD,u.qb,T.Q,T.K,T.V,T.O,T.MASK,lds); S.done(u); }
}
#undef SBAR
#undef WAIT_BAR
}

constexpr int BATCH = 8, SEQ = 2048, DM = 1024, M = BATCH * SEQ;
constexpr int NH = 8, HD = 64, AW = NH * HD, IH = 8, ID = 64, TOPK = 256, CWID = 512, DFF = 2816;
constexpr int IN_COLS = 5704, NP1 = 5888;
constexpr float EPS = 1e-6f;
constexpr float C2 = 0.125f * 1.4426950408889634f;
constexpr float IWSCALE = 0.04419417382415922f;
constexpr int NTILE = SEQ / 64;

constexpr size_t MiB = 1u << 20;
constexpr size_t WS_CTL = 0, CTL_ZERO_BYTES = 1 * MiB;
constexpr size_t WS_WIN = 2 * MiB, WS_WCAT = 14 * MiB, WS_WO = 16 * MiB, WS_WUP = 18 * MiB, WS_WDN = 29 * MiB;
constexpr size_t WS_XN = 36 * MiB;
constexpr size_t WS_IQ = 68 * MiB, WS_CH = 84 * MiB, WS_CC = 100 * MiB;
constexpr size_t WS_AC = 116 * MiB;
constexpr size_t WS_KV = 148 * MiB;
constexpr size_t WS_G = 180 * MiB;
constexpr size_t WS_IK = 244 * MiB, WS_IW = 246 * MiB;
constexpr size_t WS_MASK = 247 * MiB;
constexpr size_t WS_END = 256 * MiB;
constexpr size_t WS_T1 = 36 * MiB;
constexpr size_t WS_MRG = 148 * MiB;
constexpr size_t WS_XN2 = 36 * MiB;
constexpr size_t WS_ACT = 68 * MiB;
constexpr size_t WS_UPR = 156 * MiB;
constexpr int CW_TMO = 0, CW_CODE = 1;
constexpr int CW_BAR = 4096;

constexpr int RING_OFF = 0, RING_BYTES = 131072;
constexpr int LDSCTL_OFF = 155648, MISC_OFF = LDSCTL_OFF + 320;
constexpr int LDS_BYTES = 163840;
constexpr int NWAVES = 8;

#define GAS __attribute__((address_space(1)))
#define LAS __attribute__((address_space(3)))
typedef unsigned short bf16;
typedef unsigned v4u __attribute__((ext_vector_type(4)));
typedef unsigned v2u __attribute__((ext_vector_type(2)));
typedef float f32x4 __attribute__((ext_vector_type(4)));
typedef GAS unsigned gu32;
#define RLX_AGENT __ATOMIC_RELAXED, __HIP_MEMORY_SCOPE_AGENT
#define LDS_WAIT() asm volatile("s_waitcnt lgkmcnt(0)" ::: "memory")
#define VM_WAIT() asm volatile("s_waitcnt vmcnt(0)" ::: "memory")
__device__ __forceinline__ unsigned f2bf(float f) { unsigned u = __builtin_bit_cast(unsigned, f); return (u + 0x7fffu + ((u >> 16) & 1u)) >> 16; }
__device__ __forceinline__ unsigned pk2(float lo, float hi) { return f2bf(lo) | (f2bf(hi) << 16); }
__device__ __forceinline__ float bflo(unsigned w) { return __builtin_bit_cast(float, w << 16); }
__device__ __forceinline__ float bfhi(unsigned w) { return __builtin_bit_cast(float, w & 0xffff0000u); }
__device__ __forceinline__ float bf2f(bf16 h) { return __builtin_bit_cast(float, (unsigned)h << 16); }
__device__ __forceinline__ float wave_sum(float v) {
#pragma unroll
    for (int o = 1; o < 64; o <<= 1) v += __shfl_xor(v, o);
    return v;
}
__device__ __forceinline__ float wave_max(float v) {
#pragma unroll
    for (int o = 1; o < 64; o <<= 1) v = fmaxf(v, __shfl_xor(v, o));
    return v;
}
__device__ __forceinline__ float sigmoidf_(float x) { return __builtin_amdgcn_rcpf(1.0f + __builtin_amdgcn_exp2f(-1.4426950408889634f * x)); }

#define XB_TMO      128
#define XB_XCNT(j)  (256  + 64 * (j))
#define XB_XSUB(j)  (1280 + 64 * (j))
#define XB_XGEN(j)  (2304 + 64 * (j))
#define XB_TOP      3328
#define XB_TOPGEN   3392
#define XCD_BAR_WORDS 3456
#define XB_SPIN_CAP (1u << 18)

__device__ __forceinline__ unsigned xb_ld(unsigned* p)              { return __hip_atomic_load(p, __ATOMIC_RELAXED, __HIP_MEMORY_SCOPE_AGENT); }
__device__ __forceinline__ unsigned xb_add(unsigned* p, unsigned v) { return __hip_atomic_fetch_add(p, v, __ATOMIC_RELAXED, __HIP_MEMORY_SCOPE_AGENT); }
__device__ __forceinline__ unsigned xb_xcc_id() { return (unsigned)__builtin_amdgcn_s_getreg((3 << 11) | 20) & 0xFu; }
#define XB_SPIN(cond, bar) do { unsigned _sp = 0; while (cond) { __builtin_amdgcn_s_sleep(1); \
    if ((++_sp & 255u) == 0u) { if (xb_ld(&(bar)[XB_TMO])) break; if (_sp > XB_SPIN_CAP) { atomicAdd(&(bar)[XB_TMO], 1u); break; } } } } while (0)

struct XcdBarrier {
    unsigned* bar; unsigned x;
    volatile LAS unsigned* st;
};

__device__ __forceinline__ XcdBarrier xcd_barrier_post(unsigned* bar, volatile LAS unsigned* st) {
    XcdBarrier b; b.bar = bar; b.x = xb_xcc_id(); b.st = st;
    if (threadIdx.x == 0) (void)xb_add(&bar[XB_XCNT(b.x)], 1u);
    return b;
}
__device__ __forceinline__ void xcd_barrier_complete(unsigned* bar, unsigned x, unsigned& nloc, unsigned& nx) {
    const unsigned G = gridDim.x * gridDim.y * gridDim.z;
    unsigned sum, cnt, mine, sp = 0u;
    for (;;) {
        sum = 0u; cnt = 0u; mine = 0u;
#pragma unroll
        for (unsigned j = 0; j < 16; ++j) { const unsigned c = xb_ld(&bar[XB_XCNT(j)]); sum += c; cnt += (c > 0u) ? 1u : 0u; mine = (j == x) ? c : mine; }
        if (sum == G) break;
        __builtin_amdgcn_s_sleep(1);
        if ((++sp & 255u) == 0u) { if (xb_ld(&bar[XB_TMO])) break; if (sp > XB_SPIN_CAP) { atomicAdd(&bar[XB_TMO], 1u); break; } }
    }
    nloc = mine > 0u ? mine : 1u; nx = cnt > 0u ? cnt : 1u;
}

__device__ __forceinline__ void xcd_barrier(const XcdBarrier& b) {
    asm volatile("s_waitcnt vmcnt(0)" ::: "memory");
    __syncthreads();
    if (threadIdx.x == 0) {
        unsigned* bar = b.bar;
        __builtin_amdgcn_s_waitcnt(0);
        unsigned nloc = b.st[0], nx = b.st[1];
        if (nloc == 0u) { xcd_barrier_complete(bar, b.x, nloc, nx); b.st[0] = nloc; b.st[1] = nx; }
        const unsigned old = xb_add(&bar[XB_XSUB(b.x)], 1u);
        const unsigned gen = old / nloc;
        if (old + 1u == (gen + 1u) * nloc) {
            __builtin_amdgcn_fence(__ATOMIC_RELEASE, "agent");
            asm volatile("s_waitcnt vmcnt(0)" ::: "memory");
            const unsigned og = xb_add(&bar[XB_TOP], 1u);
            const unsigned tg = og / nx;
            if (og + 1u == (tg + 1u) * nx) xb_add(&bar[XB_TOPGEN], 1u);
            else XB_SPIN(xb_ld(&bar[XB_TOPGEN]) == tg, bar);
            __builtin_amdgcn_fence(__ATOMIC_ACQUIRE, "agent");
            xb_add(&bar[XB_XGEN(b.x)], 1u);
            asm volatile("s_waitcnt vmcnt(0)" ::: "memory");
        } else {
            XB_SPIN(xb_ld(&bar[XB_XGEN(b.x)]) == gen, bar);
            __builtin_amdgcn_fence(__ATOMIC_ACQUIRE, "agent");
            asm volatile("s_waitcnt vmcnt(0)" ::: "memory");
        }
    }
    __syncthreads();
}

using pg8::Unit;
typedef float f32x2_t __attribute__((ext_vector_type(2))); typedef __bf16 bf16x2_t __attribute__((ext_vector_type(2)));
__device__ __forceinline__ unsigned cvtpk(float lo, float hi) { const f32x2_t v = {lo, hi}; const bf16x2_t b = __builtin_convertvector(v, bf16x2_t); return __builtin_bit_cast(unsigned, b); }
__device__ __forceinline__ v4u pack8(const f32x4 a, const f32x4 b) { v4u w; w.x = cvtpk(a[0], a[1]); w.y = cvtpk(a[2], a[3]); w.z = cvtpk(b[0], b[1]); w.w = cvtpk(b[2], b[3]); return w; }
__device__ __forceinline__ void unpack8(const v4u g, f32x4& a, f32x4& b) { a = (f32x4){bflo(g.x), bfhi(g.x), bflo(g.y), bfhi(g.y)}; b = (f32x4){bflo(g.z), bfhi(g.z), bflo(g.w), bfhi(g.w)}; }

struct EpiProj {
    static constexpr bool PERM = true, AFTER_DRAIN = false;
    bf16 *AC, *KV, *IQ, *CH, *CC, *G, *IK; float* IW; const float* bgate;
    __device__ __forceinline__ void operator()(const f32x4 (&acc)[2][2][4][2], const Unit& u, int wr, int wc, int fr, int fq) const {
        const int pn = u.pn, row0 = u.pm * 256 + wr * 64 + fr, cin = wc * 32 + 8 * fq;
        if (pn < 14) {
            const int seg = pn >> 1; bf16* base; int ldc = 1024; float sc = 1.f;
            if (seg == 0) { base = AC; sc = C2; } else if (seg == 1) { base = KV; } else if (seg == 2) { base = KV + 512; }
            else if (seg == 3) { base = IQ; ldc = 512; } else if (seg == 4) { base = CH; ldc = 512; } else if (seg == 5) { base = AC + 512; } else { base = CC; ldc = 512; }
            base += (pn & 1) * 256 + cin;
#pragma unroll
            for (int ai = 0; ai < 2; ++ai)
#pragma unroll
                for (int m = 0; m < 4; ++m) { bf16* rowp = base + (size_t)(row0 + ai * 128 + m * 16) * ldc;
#pragma unroll
                    for (int bj = 0; bj < 2; ++bj) *(v4u*)(rowp + bj * 128) = pack8(acc[ai][bj][m][0] * sc, acc[ai][bj][m][1] * sc); }
        } else if (pn < 22) {
            const int gc = (pn - 14) * 256 + cin;
            f32x4 bv[2][2];
#pragma unroll
            for (int bj = 0; bj < 2; ++bj)
#pragma unroll
                for (int n = 0; n < 2; ++n) bv[bj][n] = *(const f32x4*)(bgate + gc + bj * 128 + 4 * n);
#pragma unroll
            for (int ai = 0; ai < 2; ++ai)
#pragma unroll
                for (int m = 0; m < 4; ++m) { bf16* rowp = G + (size_t)(row0 + ai * 128 + m * 16) * 2048 + gc;
#pragma unroll
                    for (int bj = 0; bj < 2; ++bj) { f32x4 v0 = acc[ai][bj][m][0] + bv[bj][0], v1 = acc[ai][bj][m][1] + bv[bj][1];
#pragma unroll
                        for (int e = 0; e < 4; ++e) { v0[e] = sigmoidf_(v0[e]); v1[e] = sigmoidf_(v1[e]); }
                        *(v4u*)(rowp + bj * 128) = pack8(v0, v1); } }
        } else {
            if (wc < 2) {
#pragma unroll
                for (int ai = 0; ai < 2; ++ai)
#pragma unroll
                    for (int m = 0; m < 4; ++m) *(v4u*)(IK + (size_t)(row0 + ai * 128 + m * 16) * 64 + cin) = pack8(acc[ai][0][m][0], acc[ai][0][m][1]);
            } else if (wc == 2 && fq == 0) {
#pragma unroll
                for (int ai = 0; ai < 2; ++ai)
#pragma unroll
                    for (int m = 0; m < 4; ++m) { float* p = IW + (size_t)(row0 + ai * 128 + m * 16) * 8; *(f32x4*)p = acc[ai][0][m][0] * IWSCALE; *(f32x4*)(p + 4) = acc[ai][0][m][1] * IWSCALE; }
            }
        }
    }
};
struct EpiGateA {
    static constexpr bool PERM = true, AFTER_DRAIN = false;
    float* T1; const bf16* G;
    __device__ __forceinline__ void operator()(const f32x4 (&acc)[2][2][4][2], const Unit& u, int wr, int wc, int fr, int fq) const {
        const int row0 = u.pm * 256 + wr * 64 + fr, c0 = u.pn * 256 + wc * 32 + 8 * fq;
#pragma unroll
        for (int ai = 0; ai < 2; ++ai)
#pragma unroll
            for (int m = 0; m < 4; ++m) { const int row = row0 + ai * 128 + m * 16;
#pragma unroll
                for (int bj = 0; bj < 2; ++bj) { const int col = c0 + bj * 128; f32x4 g0, g1; unpack8(*(const v4u*)(G + (size_t)row * 2048 + col), g0, g1);
                    float* p = T1 + (size_t)row * 1024 + col; *(f32x4*)p = acc[ai][bj][m][0] * g0; *(f32x4*)(p + 4) = acc[ai][bj][m][1] * g1; }
                asm volatile("" ::: "memory"); }
    }
};
struct EpiGateC {
    static constexpr bool PERM = true, AFTER_DRAIN = false;
    const float* T1; const bf16* G; bf16* MRG;
    __device__ __forceinline__ void operator()(const f32x4 (&acc)[2][2][4][2], const Unit& u, int wr, int wc, int fr, int fq) const {
        const int row0 = u.pm * 256 + wr * 64 + fr, c0 = u.pn * 256 + wc * 32 + 8 * fq;
#pragma unroll
        for (int ai = 0; ai < 2; ++ai)
#pragma unroll
            for (int m = 0; m < 4; ++m) { const int row = row0 + ai * 128 + m * 16;
#pragma unroll
                for (int bj = 0; bj < 2; ++bj) { const int col = c0 + bj * 128; f32x4 g0, g1; unpack8(*(const v4u*)(G + (size_t)row * 2048 + 1024 + col), g0, g1);
                    const float* p = T1 + (size_t)row * 1024 + col; const f32x4 t0 = *(const f32x4*)p, t1 = *(const f32x4*)(p + 4);
                    *(v4u*)(MRG + (size_t)row * 1024 + col) = pack8(t0 + acc[ai][bj][m][0] * g0, t1 + acc[ai][bj][m][1] * g1); }
                asm volatile("" ::: "memory"); }
    }
};
struct EpiResid {
    static constexpr bool PERM = false, AFTER_DRAIN = false;
    const float* X; float* O;
    __device__ __forceinline__ void operator()(const f32x4 (&acc)[2][2][4][2], const Unit& u, int wr, int wc, int fr, int fq) const {
        const int row0 = u.pm * 256 + wr * 64 + fr, c0 = u.pn * 256 + wc * 32 + 4 * fq;
#pragma unroll
        for (int ai = 0; ai < 2; ++ai)
#pragma unroll
            for (int m = 0; m < 4; ++m) { const size_t off = (size_t)(row0 + ai * 128 + m * 16) * 1024 + c0;
#pragma unroll
                for (int bj = 0; bj < 2; ++bj)
#pragma unroll
                    for (int n = 0; n < 2; ++n) { const f32x4 xv = *(const f32x4*)(X + off + bj * 128 + n * 16); *(f32x4*)(O + off + bj * 128 + n * 16) = xv + acc[ai][bj][m][n]; }
                asm volatile("" ::: "memory"); }
    }
};
struct EpiRawBf16 {
    static constexpr bool PERM = true, AFTER_DRAIN = false;
    bf16* O; int ldc;
    __device__ __forceinline__ void operator()(const f32x4 (&acc)[2][2][4][2], const Unit& u, int wr, int wc, int fr, int fq) const {
        const int row0 = u.pm * 256 + wr * 64 + fr, c0 = u.pn * 256 + wc * 32 + 8 * fq;
#pragma unroll
        for (int ai = 0; ai < 2; ++ai)
#pragma unroll
            for (int m = 0; m < 4; ++m) { bf16* rowp = O + (size_t)(row0 + ai * 128 + m * 16) * ldc + c0;
#pragma unroll
                for (int bj = 0; bj < 2; ++bj) *(v4u*)(rowp + bj * 128) = pack8(acc[ai][bj][m][0], acc[ai][bj][m][1]); }
    }
};

struct Frame {
    LAS unsigned char* lds;
    int tid, lane, wave, vcu, G;
    const float *x, *g1, *w_in, *b_gate, *w_ao, *conv_w, *w_co, *w_o, *g2, *w_up, *fconv_w, *w_dn, *g3; float* out;
    bf16 *WIN, *WCAT, *WO, *WUP, *WDN, *XN, *IQ, *CH, *CC, *AC, *KV, *GG, *IK, *MRG, *XN2, *ACT, *UPR; float *IW, *T1; unsigned* MASK;
};

struct ColId { __device__ __forceinline__ int operator()(int d) const { return d; } };
struct ColWin { __device__ __forceinline__ int operator()(int d) const {
    if (d < 2048) return d;
    if (d < 5632) return d + 72;
    if (d < 5696) return d - 5632 + 2048;
    if (d < 5704) return d - 5696 + 2112;
    return -1; } };
struct ColWup { __device__ __forceinline__ int operator()(int d) const { const int j = d >> 8, i = d & 255; return i < 128 ? 128 * j + i : DFF + 128 * j + (i - 128); } };
template <class CM> __device__ __forceinline__ void transpose_item(const float* W, int Nsrc, bf16* WT, int ldt, int koff, int kb, int db, LAS float* scr, int lane, const CM cm) {
    const int k0 = 64 * kb, d0 = 32 * db; const int sc = cm(d0 + (lane & 31));
#pragma unroll 8
    for (int i = 0; i < 32; ++i) { const int kk = 2 * i + (lane >> 5); scr[kk * 33 + (lane & 31)] = sc >= 0 ? W[(size_t)(k0 + kk) * Nsrc + sc] : 0.f; }
    LDS_WAIT(); asm volatile("" ::: "memory");
    const int c = lane & 7;
#pragma unroll
    for (int j = 0; j < 4; ++j) { const int n = (lane >> 3) + 8 * j; const LAS float* s = scr + (8 * c) * 33 + n;
        v4u o; o.x = pk2(s[0 * 33], s[1 * 33]); o.y = pk2(s[2 * 33], s[3 * 33]); o.z = pk2(s[4 * 33], s[5 * 33]); o.w = pk2(s[6 * 33], s[7 * 33]);
        *(GAS v4u*)(WT + (size_t)(d0 + n) * ldt + koff + k0 + 8 * c) = o; }
    LDS_WAIT(); asm volatile("" ::: "memory");
}
__device__ __forceinline__ void rms_row_to_bf16(const float* xrow, const float* g, bf16* orow, int lane) {
    const GAS f32x4* xr = (const GAS f32x4*)xrow + lane; const GAS f32x4* gr = (const GAS f32x4*)g + lane;
    f32x4 v[4]; float s = 0.f;
#pragma unroll
    for (int j = 0; j < 4; ++j) { v[j] = xr[64 * j]; s += (v[j].x * v[j].x + v[j].y * v[j].y) + (v[j].z * v[j].z + v[j].w * v[j].w); }
    const float rstd = 1.0f / sqrtf(wave_sum(s) * (1.0f / DM) + EPS);
    GAS unsigned long long* o8 = (GAS unsigned long long*)orow + lane;
#pragma unroll
    for (int j = 0; j < 4; ++j) { const f32x4 gv = gr[64 * j]; o8[64 * j] = (unsigned long long)pk2(v[j].x * rstd * gv.x, v[j].y * rstd * gv.y) | ((unsigned long long)pk2(v[j].z * rstd * gv.z, v[j].w * rstd * gv.w) << 32); }
}
__device__ __forceinline__ void rms_row_to_f32(const float* xrow, const float* g, float* orow, int lane) {
    const GAS f32x4* xr = (const GAS f32x4*)xrow + lane; const GAS f32x4* gr = (const GAS f32x4*)g + lane;
    f32x4 v[4]; float s = 0.f;
#pragma unroll
    for (int j = 0; j < 4; ++j) { v[j] = xr[64 * j]; s += (v[j].x * v[j].x + v[j].y * v[j].y) + (v[j].z * v[j].z + v[j].w * v[j].w); }
    const float rstd = 1.0f / sqrtf(wave_sum(s) * (1.0f / DM) + EPS);
    GAS f32x4* o4 = (GAS f32x4*)orow + lane;
#pragma unroll
    for (int j = 0; j < 4; ++j) { const f32x4 gv = gr[64 * j]; o4[64 * j] = v[j] * rstd * gv; }
}
__device__ __forceinline__ void p0_prologue(Frame& F) {
    LAS float* scr = (LAS float*)(F.lds + RING_OFF + F.wave * 16384);
    const int gw = F.vcu * NWAVES + F.wave, NGW = F.G * NWAVES;
    constexpr int I_IN = 16 * (NP1 / 32), I_AO = 8 * 32, I_CO = 8 * 32, I_O = 16 * 32, I_UP = 16 * (2 * DFF / 32), I_DN = (DFF / 64) * 32;
    constexpr int NITEMS = I_IN + I_AO + I_CO + I_O + I_UP + I_DN;
    for (int it = gw; it < NITEMS; it += NGW) {
        int r = it;
        if (r < I_IN) { transpose_item(F.w_in, IN_COLS, F.WIN, 1024, 0, r / (NP1 / 32), r % (NP1 / 32), scr, F.lane, ColWin()); continue; } r -= I_IN;
        if (r < I_AO) { transpose_item(F.w_ao, 1024, F.WCAT, 1024, 0, r / 32, r % 32, scr, F.lane, ColId()); continue; } r -= I_AO;
        if (r < I_CO) { transpose_item(F.w_co, 1024, F.WCAT, 1024, 512, r / 32, r % 32, scr, F.lane, ColId()); continue; } r -= I_CO;
        if (r < I_O) { transpose_item(F.w_o, 1024, F.WO, 1024, 0, r / 32, r % 32, scr, F.lane, ColId()); continue; } r -= I_O;
        if (r < I_UP) { transpose_item(F.w_up, 2 * DFF, F.WUP, 1024, 0, r / (2 * DFF / 32), r % (2 * DFF / 32), scr, F.lane, ColWup()); continue; } r -= I_UP;
        transpose_item(F.w_dn, 1024, F.WDN, DFF, 0, r / 32, r % 32, scr, F.lane, ColId());
    }
    for (int m = gw; m < M; m += NGW) rms_row_to_bf16(F.x + (size_t)m * DM, F.g1, F.XN + (size_t)m * DM, F.lane);
}

__device__ __forceinline__ unsigned compact_nib(unsigned long long x) {
    x &= 0x0F0F0F0F0F0F0F0FULL; x = (x | (x >> 4)) & 0x00FF00FF00FF00FFULL; x = (x | (x >> 8)) & 0x0000FFFF0000FFFFULL; x = (x | (x >> 16)) & 0x00000000FFFFFFFFULL; return (unsigned)x;
}
__device__ __forceinline__ void select_row_emit(const LAS float* srow, LAS unsigned* hist, int q, int lane, unsigned* maskq) {
    unsigned key[32];
#pragma unroll
    for (int j = 0; j < 32; ++j) { const int idx = 64 * j + lane; const unsigned u = __builtin_bit_cast(unsigned, srow[idx]); const unsigned k = u ^ ((u >> 31) ? 0xffffffffu : 0x80000000u); key[j] = (idx <= q) ? k : 0u; }
    unsigned T = 1u, need = 0u, cnteq = 0u;
    const bool all = (q < TOPK);
    if (!all) {
        unsigned prefix = 0u, kth = TOPK;
#pragma unroll
        for (int pass = 0; pass < 4; ++pass) {
            const int shift = 24 - 8 * pass;
            *(LAS v4u*)(hist + 4 * lane) = (v4u){0u, 0u, 0u, 0u};
            LDS_WAIT();
#pragma unroll
            for (int j = 0; j < 32; ++j) {
                const unsigned hiw = (pass == 0) ? 0u : (key[j] >> ((shift + 8) & 31));
                if (hiw == prefix) __hip_atomic_fetch_add(hist + ((key[j] >> shift) & 255u), 1u, __ATOMIC_RELAXED, __HIP_MEMORY_SCOPE_WORKGROUP);
            }
            LDS_WAIT();
            const v4u c = *(const LAS v4u*)(hist + 4 * lane);
            const unsigned s = c.x + c.y + c.z + c.w;
            unsigned S = s;
#pragma unroll
            for (int o = 1; o < 64; o <<= 1) { const unsigned t = __shfl_down(S, o); if (lane + o < 64) S += t; }
            const unsigned above = S - s;
            const bool mine = (above < kth) && (kth <= S);
            unsigned mybin = 0u, mykth = 0u, mycnt = 0u;
            { unsigned cum = above; bool found = false;
              if (cum + c.w >= kth) { mybin = 4 * lane + 3; mykth = kth - cum; mycnt = c.w; found = true; } else cum += c.w;
              if (!found) { if (cum + c.z >= kth) { mybin = 4 * lane + 2; mykth = kth - cum; mycnt = c.z; found = true; } else cum += c.z; }
              if (!found) { if (cum + c.y >= kth) { mybin = 4 * lane + 1; mykth = kth - cum; mycnt = c.y; found = true; } else cum += c.y; }
              if (!found) { mybin = 4 * lane; mykth = kth - cum; mycnt = c.x; } }
            const unsigned long long bal = __ballot(mine);
            const int src = __ffsll((long long)bal) - 1;
            const unsigned bin = __shfl(mybin, src); kth = __shfl(mykth, src); cnteq = __shfl(mycnt, src);
            prefix = (prefix << 8) | bin;
        }
        T = prefix; need = kth;
    }
    const bool ties = (!all) && (cnteq > need);
    unsigned mw0 = 0u, mw1 = 0u, taken = 0u;
#pragma unroll
    for (int j = 0; j < 32; ++j) {
        bool sel;
        if (!ties) sel = key[j] >= T;
        else { const bool eq = key[j] == T; const unsigned long long be = __ballot(eq);
               const unsigned rank = taken + __builtin_amdgcn_mbcnt_hi((unsigned)(be >> 32), __builtin_amdgcn_mbcnt_lo((unsigned)be, 0u));
               sel = key[j] > T || (eq && rank < need); taken += (unsigned)__builtin_popcountll(be); }
        const unsigned long long m64 = __ballot(sel);
        const unsigned w0 = compact_nib(m64), w1 = compact_nib(m64 >> 4);
        if (lane == j) { mw0 = w0; mw1 = w1; }
    }
    if (lane < 32) *(v2u*)(maskq + (size_t)lane * (SEQ * 2)) = (v2u){mw0, mw1};
}
__device__ __forceinline__ void naive_scores_row(const Frame& F, int b, int q, LAS float* srow, LAS float* iqf, int lane) {
    { const v4u w = *(const v4u*)(F.IQ + (size_t)(b * SEQ + q) * 512 + lane * 8); LAS float* d = iqf + lane * 8;
      d[0] = bflo(w.x); d[1] = bfhi(w.x); d[2] = bflo(w.y); d[3] = bfhi(w.y); d[4] = bflo(w.z); d[5] = bfhi(w.z); d[6] = bflo(w.w); d[7] = bfhi(w.w); }
    float iw[8];
#pragma unroll
    for (int h = 0; h < 8; ++h) iw[h] = F.IW[(size_t)(b * SEQ + q) * 8 + h];
    LDS_WAIT(); asm volatile("" ::: "memory");
    const int nj = (q >> 6) + 1;
    for (int j = 0; j < nj; ++j) {
        const int k = 64 * j + lane;
        const v4u* kp = (const v4u*)(F.IK + (size_t)(b * SEQ + k) * 64);
        float kf[64];
#pragma unroll
        for (int c = 0; c < 8; ++c) { const v4u w = kp[c]; kf[8 * c + 0] = bflo(w.x); kf[8 * c + 1] = bfhi(w.x); kf[8 * c + 2] = bflo(w.y); kf[8 * c + 3] = bfhi(w.y); kf[8 * c + 4] = bflo(w.z); kf[8 * c + 5] = bfhi(w.z); kf[8 * c + 6] = bflo(w.w); kf[8 * c + 7] = bfhi(w.w); }
        float sc = 0.f;
#pragma unroll
        for (int h = 0; h < 8; ++h) { float d = 0.f;
#pragma unroll
            for (int dd = 0; dd < 64; ++dd) d = fmaf(iqf[h * 64 + dd], kf[dd], d);
            sc = fmaf(fmaxf(d, 0.f), iw[h], sc); }
        srow[k] = sc;
    }
    LDS_WAIT(); asm volatile("" ::: "memory");
}
__device__ __forceinline__ void p2_index_select_naive(Frame& F) {
    const int gw = F.vcu * NWAVES + F.wave, NGW = F.G * NWAVES;
    LAS float* srow = (LAS float*)(F.lds + F.wave * 8192);
    LAS unsigned* hist = (LAS unsigned*)(F.lds + 65536 + F.wave * 1024);
    LAS float* iqf = (LAS float*)(F.lds + 73728 + F.wave * 2048);
    for (int r = gw; r < M; r += NGW) {
        const int b = r / SEQ, qq = r % SEQ, q = (b & 1) ? (SEQ - 1 - qq) : qq;
        naive_scores_row(F, b, q, srow, iqf, F.lane);
        select_row_emit(srow, hist, q, F.lane, F.MASK + ((size_t)(b * NTILE) * SEQ + q) * 2);
    }
}
typedef short bf16x8_t __attribute__((ext_vector_type(8)));
typedef float f32x16_t __attribute__((ext_vector_type(16)));
__device__ __forceinline__ void p2_index_select_mfma(Frame& F) {
    const int lane = F.lane, wid = F.wave, c = lane & 31, hh = lane >> 5;
    LAS float* sc = (LAS float*)(F.lds);
    LAS unsigned* hist = (LAS unsigned*)(F.lds + 131072 + wid * 1024);
    for (int i = 0;; ++i) {
        const int pr = F.vcu + (i >> 1) * F.G; if (pr >= BATCH * 64) break;
        const int b = pr >> 6, s = pr & 63, ub = (i & 1) ? 127 - s : s, q0 = 16 * ub;
        const size_t rowb = (size_t)b * SEQ;
        bf16x8_t A[4][4]; f32x4 w[4][4];
#pragma unroll
        for (int mb = 0; mb < 4; ++mb) {
#pragma unroll
            for (int ks = 0; ks < 4; ++ks) A[mb][ks] = *(const bf16x8_t*)(F.IQ + (rowb + q0) * 512 + (32 * mb + c) * 64 + 16 * ks + 8 * hh);
#pragma unroll
            for (int g = 0; g < 4; ++g) w[mb][g] = *(const f32x4*)(F.IW + (rowb + q0 + 4 * mb + g) * 8 + 4 * hh);
        }
        const int n32 = (q0 + 16 + 31) >> 5;
        for (int kt = wid; kt < n32; kt += NWAVES) {
            bf16x8_t B[4];
#pragma unroll
            for (int ks = 0; ks < 4; ++ks) B[ks] = *(const bf16x8_t*)(F.IK + (rowb + 32 * kt + c) * 64 + 16 * ks + 8 * hh);
#pragma unroll
            for (int mb = 0; mb < 4; ++mb) {
                f32x16_t acc = {};
#pragma unroll
                for (int ks = 0; ks < 4; ++ks) acc = __builtin_amdgcn_mfma_f32_32x32x16_bf16(A[mb][ks], B[ks], acc, 0, 0, 0);
                float part[4];
#pragma unroll
                for (int g = 0; g < 4; ++g) { float p = 0.f;
#pragma unroll
                    for (int e = 0; e < 4; ++e) p = fmaf(fmaxf(acc[4 * g + e], 0.f), w[mb][g][e], p);
                    part[g] = p + __shfl_xor(p, 32); }
                const float v0 = hh ? part[2] : part[0], v1 = hh ? part[3] : part[1];
                sc[(4 * mb + 2 * hh) * 2048 + 32 * kt + c] = v0; sc[(4 * mb + 2 * hh + 1) * 2048 + 32 * kt + c] = v1;
            }
        }
        __syncthreads();
#pragma unroll 1
        for (int rr = 0; rr < 2; ++rr) { const int ql = 2 * wid + rr, q = q0 + ql;
            select_row_emit(sc + ql * 2048, hist, q, lane, F.MASK + ((size_t)(b * NTILE) * SEQ + q) * 2); }
        __syncthreads();
    }
}
__device__ __forceinline__ void p2_conv_mixer(Frame& F) {
    const int gt = F.vcu * (NWAVES * 64) + F.tid, NT_ = F.G * NWAVES * 64;
    for (int it = gt; it < M * 64; it += NT_) {
        const int t = it >> 6, c0 = (it & 63) * 8, s = t & (SEQ - 1);
        float a[8];
#pragma unroll
        for (int e = 0; e < 8; ++e) a[e] = 0.f;
#pragma unroll
        for (int j = 0; j < 3; ++j) {
            if (s - 2 + j >= 0) {
                f32x4 h0, h1, c0v, c1v; unpack8(*(const v4u*)(F.CH + (size_t)(t - 2 + j) * 512 + c0), h0, h1); unpack8(*(const v4u*)(F.CC + (size_t)(t - 2 + j) * 512 + c0), c0v, c1v);
                const f32x4 w0 = *(const f32x4*)(F.conv_w + j * 512 + c0), w1 = *(const f32x4*)(F.conv_w + j * 512 + c0 + 4);
#pragma unroll
                for (int e = 0; e < 4; ++e) { a[e] = fmaf(w0[e], h0[e] * c0v[e], a[e]); a[4 + e] = fmaf(w1[e], h1[e] * c1v[e], a[4 + e]); }
            }
        }
        bf16* p = F.AC + (size_t)t * 1024 + 512 + c0; f32x4 b0, b1; unpack8(*(const v4u*)p, b0, b1);
        v4u o; o.x = pk2(b0[0] * a[0], b0[1] * a[1]); o.y = pk2(b0[2] * a[2], b0[3] * a[3]); o.z = pk2(b1[0] * a[4], b1[1] * a[5]); o.w = pk2(b1[2] * a[6], b1[3] * a[7]);
        *(v4u*)p = o;
    }
}
__device__ __forceinline__ void p3_attention_naive(Frame& F) {
    const int gw = F.vcu * NWAVES + F.wave, NGW = F.G * NWAVES, lane = F.lane;
    const int hi = (lane >> 2) & 1, eb = 16 * (lane >> 5) + 4 * ((lane >> 3) & 3) + (lane & 3);
    LAS float* slog = (LAS float*)(F.lds + F.wave * 8192);
    for (int r = gw; r < M; r += NGW) {
        const int b = r / SEQ, qq = r % SEQ, q = (b & 1) ? (SEQ - 1 - qq) : qq;
        const int nj = (q >> 6) + 1;
        const unsigned* maskq = F.MASK + ((size_t)(b * NTILE) * SEQ + q) * 2;
        unsigned selbits = 0u;
        for (int j = 0; j < nj; ++j) { const unsigned w = maskq[(size_t)j * (SEQ * 2) + hi]; selbits |= ((w >> eb) & 1u) << j; }
        bf16* qrow = F.AC + (size_t)(b * SEQ + q) * 1024;
        for (int h = 0; h < NH; ++h) {
            float qf[64];
#pragma unroll
            for (int c = 0; c < 8; ++c) { const v4u w = *(const v4u*)(qrow + h * 64 + c * 8); qf[8 * c + 0] = bflo(w.x); qf[8 * c + 1] = bfhi(w.x); qf[8 * c + 2] = bflo(w.y); qf[8 * c + 3] = bfhi(w.y); qf[8 * c + 4] = bflo(w.z); qf[8 * c + 5] = bfhi(w.z); qf[8 * c + 6] = bflo(w.w); qf[8 * c + 7] = bfhi(w.w); }
            float mx = -INFINITY;
            for (int j = 0; j < nj; ++j) {
                const v4u* kp = (const v4u*)(F.KV + (size_t)(b * SEQ + 64 * j + lane) * 1024 + h * 64); float d = 0.f;
#pragma unroll
                for (int c = 0; c < 8; ++c) { const v4u w = kp[c]; d = fmaf(qf[8 * c + 0], bflo(w.x), d); d = fmaf(qf[8 * c + 1], bfhi(w.x), d); d = fmaf(qf[8 * c + 2], bflo(w.y), d); d = fmaf(qf[8 * c + 3], bfhi(w.y), d);
                    d = fmaf(qf[8 * c + 4], bflo(w.z), d); d = fmaf(qf[8 * c + 5], bfhi(w.z), d); d = fmaf(qf[8 * c + 6], bflo(w.w), d); d = fmaf(qf[8 * c + 7], bfhi(w.w), d); }
                const float l = ((selbits >> j) & 1u) ? d : -INFINITY;
                slog[64 * j + lane] = l; mx = fmaxf(mx, l);
            }
            mx = wave_max(mx);
            float sum = 0.f;
            for (int j = 0; j < nj; ++j) { const float l = slog[64 * j + lane]; const float p = (l == -INFINITY) ? 0.f : __builtin_amdgcn_exp2f(l - mx); slog[64 * j + lane] = p; sum += p; }
            sum = wave_sum(sum);
            LDS_WAIT(); asm volatile("" ::: "memory");
            float o = 0.f;
            const bf16* vp = F.KV + (size_t)(b * SEQ) * 1024 + 512 + h * 64 + lane;
            for (int k = 0; k < 64 * nj; ++k) { const float pk = slog[k]; if (__builtin_amdgcn_readfirstlane(__builtin_bit_cast(int, pk)) != 0) o = fmaf(pk, bf2f(vp[(size_t)k * 1024]), o); }
            qrow[h * 64 + lane] = (bf16)f2bf(o / sum);
            LDS_WAIT(); asm volatile("" ::: "memory");
        }
    }
}
__device__ __forceinline__ void p_rows_norm_bf16(Frame& F, const float* src, const float* g, bf16* dst) {
    const int gw = F.vcu * NWAVES + F.wave, NGW = F.G * NWAVES;
    for (int m = gw; m < M; m += NGW) rms_row_to_bf16(src + (size_t)m * DM, g, dst + (size_t)m * DM, F.lane);
}
__device__ __forceinline__ void p_rows_norm_f32(Frame& F, float* io, const float* g) {
    const int gw = F.vcu * NWAVES + F.wave, NGW = F.G * NWAVES;
    for (int m = gw; m < M; m += NGW) rms_row_to_f32(io + (size_t)m * DM, g, io + (size_t)m * DM, F.lane);
}
__device__ __forceinline__ void p_act_chunk(Frame& F, int chunk) {
    const int gt = F.vcu * (NWAVES * 64) + F.tid, NT_ = F.G * NWAVES * 64;
    constexpr int FPR = DFF / 8;
    for (int it = gt; it < (M / 2) * FPR; it += NT_) {
        const int tl = it / FPR, f0 = (it % FPR) * 8, t = chunk * (M / 2) + tl, s = t & (SEQ - 1);
        const int colg = 256 * (f0 >> 7) + (f0 & 127);
        float ag[8], av[8];
#pragma unroll
        for (int e = 0; e < 8; ++e) { ag[e] = 0.f; av[e] = 0.f; }
#pragma unroll
        for (int j = 0; j < 3; ++j) {
            if (s - 2 + j >= 0) {
                const bf16* rp = F.UPR + (size_t)(tl - 2 + j) * (2 * DFF) + colg;
                f32x4 g0, g1, v0, v1; unpack8(*(const v4u*)rp, g0, g1); unpack8(*(const v4u*)(rp + 128), v0, v1);
                const float* wg = F.fconv_w + (size_t)j * (2 * DFF) + f0; const float* wv = wg + DFF;
                const f32x4 wg0 = *(const f32x4*)wg, wg1 = *(const f32x4*)(wg + 4), wv0 = *(const f32x4*)wv, wv1 = *(const f32x4*)(wv + 4);
#pragma unroll
                for (int e = 0; e < 4; ++e) { ag[e] = fmaf(wg0[e], g0[e], ag[e]); ag[4 + e] = fmaf(wg1[e], g1[e], ag[4 + e]); av[e] = fmaf(wv0[e], v0[e], av[e]); av[4 + e] = fmaf(wv1[e], v1[e], av[4 + e]); }
            }
        }
        float r[8];
#pragma unroll
        for (int e = 0; e < 8; ++e) r[e] = ag[e] * sigmoidf_(ag[e]) * av[e];
        v4u o; o.x = pk2(r[0], r[1]); o.y = pk2(r[2], r[3]); o.z = pk2(r[4], r[5]); o.w = pk2(r[6], r[7]);
        *(v4u*)(F.ACT + (size_t)t * DFF + f0) = o;
    }
}

struct Args { const float* in[13]; float* out; unsigned char* ws; int ph_lo, ph_hi; };
constexpr int N_PHASES = 13;
__global__ void __launch_bounds__(NWAVES * 64, 2) fwd_kernel(Args args) {
    extern __shared__ __attribute__((aligned(16))) unsigned char lds[];
    Frame F;
    F.lds = (LAS unsigned char*)lds;
    volatile LAS unsigned* MISC = (volatile LAS unsigned*)(F.lds + MISC_OFF);
    F.tid = threadIdx.x; F.lane = F.tid & 63; F.wave = __builtin_amdgcn_readfirstlane(F.tid >> 6);
    F.G = gridDim.x; { const int bx = blockIdx.x; F.vcu = (F.G % 8 == 0) ? (bx % 8) * (F.G / 8) + bx / 8 : bx; }
    unsigned char* ws = args.ws;
    gu32* ctl = (gu32*)(ws + WS_CTL);
    F.x = args.in[0]; F.g1 = args.in[1]; F.w_in = args.in[2]; F.b_gate = args.in[3]; F.w_ao = args.in[4]; F.conv_w = args.in[5]; F.w_co = args.in[6]; F.w_o = args.in[7];
    F.g2 = args.in[8]; F.w_up = args.in[9]; F.fconv_w = args.in[10]; F.w_dn = args.in[11]; F.g3 = args.in[12]; F.out = args.out;
    F.WIN = (bf16*)(ws + WS_WIN); F.WCAT = (bf16*)(ws + WS_WCAT); F.WO = (bf16*)(ws + WS_WO); F.WUP = (bf16*)(ws + WS_WUP); F.WDN = (bf16*)(ws + WS_WDN);
    F.XN = (bf16*)(ws + WS_XN); F.IQ = (bf16*)(ws + WS_IQ); F.CH = (bf16*)(ws + WS_CH); F.CC = (bf16*)(ws + WS_CC); F.AC = (bf16*)(ws + WS_AC); F.KV = (bf16*)(ws + WS_KV);
    F.GG = (bf16*)(ws + WS_G); F.IK = (bf16*)(ws + WS_IK); F.IW = (float*)(ws + WS_IW); F.MASK = (unsigned*)(ws + WS_MASK);
    F.T1 = (float*)(ws + WS_T1); F.MRG = (bf16*)(ws + WS_MRG); F.XN2 = (bf16*)(ws + WS_XN2); F.ACT = (bf16*)(ws + WS_ACT); F.UPR = (bf16*)(ws + WS_UPR);
    for (int u = F.tid; u < (LDS_BYTES - LDSCTL_OFF) / 4; u += NWAVES * 64) ((LAS unsigned*)(F.lds + LDSCTL_OFF))[u] = 0u;
    __syncthreads();
    XcdBarrier bar = xcd_barrier_post((unsigned*)(ctl + CW_BAR), MISC + 8);
    const int lo = args.ph_lo, hi = args.ph_hi;
#define IN(k) (lo <= (k) && (k) < hi)
#define SEAM(k) do { if (IN(k) && IN((k) + 1)) xcd_barrier(bar); } while (0)

    if (IN(0)) { p0_prologue(F); } SEAM(0);
    if (IN(1)) {
        pg8::Gemm g{F.XN, F.WIN, M, NP1, 1024, 1024, 1024}; pg8::StaticOrder S; S.init(M, NP1, F.G, (int)blockIdx.x);
        EpiProj E{F.AC, F.KV, F.IQ, F.CH, F.CC, F.GG, F.IK, F.IW, F.b_gate};
        pg8::gemm_phase<EpiProj, pg8::StaticOrder, true, true>(F.lds + RING_OFF, g, S, E);
    } SEAM(1);
    #if defined(NAIVE_INDEX)
    if (IN(2)) { p2_index_select_naive(F); p2_conv_mixer(F); } SEAM(2);
#else
    if (IN(2)) { p2_index_select_mfma(F); p2_conv_mixer(F); } SEAM(2);
#endif
    if (IN(3)) {
#if defined(NAIVE_ATTN)
        p3_attention_naive(F);
#else
        static_assert(attn_body::ATTN_LDS_BYTES <= LDSCTL_OFF, "attention LDS");
        const attn_body::AttnTensors AT{(const attn_body::bf16*)F.AC, (const attn_body::bf16*)F.KV, (const attn_body::bf16*)(F.KV + 512), (attn_body::bf16*)F.AC, F.MASK};
        const attn_body::StaticOrder S((int)F.G, (int)blockIdx.x);
        attn_body::attn_phase<attn_body::StaticOrder>((char*)lds + RING_OFF, AT, S);
#endif
    } SEAM(3);
    if (IN(4)) {
        { pg8::Gemm g{F.AC, F.WCAT, M, 1024, 512, 1024, 1024}; pg8::StaticOrder S; S.init(M, 1024, F.G, (int)blockIdx.x);
          EpiGateA E{F.T1, F.GG}; pg8::gemm_phase<EpiGateA, pg8::StaticOrder, false, true>(F.lds + RING_OFF, g, S, E); }
        VM_WAIT(); __syncthreads();
        { pg8::Gemm g{F.AC + 512, F.WCAT + 512, M, 1024, 512, 1024, 1024}; pg8::StaticOrder S; S.init(M, 1024, F.G, (int)blockIdx.x);
          EpiGateC E{F.T1, F.GG, F.MRG}; pg8::gemm_phase<EpiGateC, pg8::StaticOrder, false, true>(F.lds + RING_OFF, g, S, E); }
    } SEAM(4);
    if (IN(5)) {
        pg8::Gemm g{F.MRG, F.WO, M, 1024, 1024, 1024, 1024}; pg8::StaticOrder S; S.init(M, 1024, F.G, (int)blockIdx.x);
        EpiResid E{F.x, F.out}; pg8::gemm_phase<EpiResid, pg8::StaticOrder, false, true>(F.lds + RING_OFF, g, S, E);
    } SEAM(5);
    if (IN(6)) { p_rows_norm_bf16(F, F.out, F.g2, F.XN2); } SEAM(6);
    for (int chunk = 0; chunk < 2; ++chunk) {
        if (IN(7 + 2 * chunk)) {
            pg8::Gemm g{F.XN2 + (size_t)chunk * (M / 2) * 1024, F.WUP, M / 2, 2 * DFF, 1024, 1024, 1024}; pg8::StaticOrder S; S.init(M / 2, 2 * DFF, F.G, (int)blockIdx.x);
            EpiRawBf16 E{F.UPR, 2 * DFF}; pg8::gemm_phase<EpiRawBf16, pg8::StaticOrder, true, true>(F.lds + RING_OFF, g, S, E);
        } SEAM(7 + 2 * chunk);
        if (IN(8 + 2 * chunk)) { p_act_chunk(F, chunk); } SEAM(8 + 2 * chunk);
    }
    if (IN(11)) {
        pg8::Gemm g{F.ACT, F.WDN, M, 1024, DFF, DFF, DFF}; pg8::StaticOrder S; S.init(M, 1024, F.G, (int)blockIdx.x);
        EpiResid E{F.out, F.out}; pg8::gemm_phase<EpiResid, pg8::StaticOrder, false, true>(F.lds + RING_OFF, g, S, E);
    } SEAM(11);
    if (IN(12)) { p_rows_norm_f32(F, F.out, F.g3); }
#undef IN
#undef SEAM
}

#ifndef MK_N_LAUNCHES
#define MK_N_LAUNCHES 1
#endif
extern "C" void kernel_launch(void* const* d_in, const int* in_sizes, int n_in, void* d_out, int out_size, void* d_ws, size_t ws_size, hipStream_t stream) {
    static int grid = 0;
    if (grid == 0) {
        if (n_in != 13 || in_sizes[0] != M * DM || out_size != M * DM || ws_size < WS_END) { fprintf(stderr, "kernel_launch: unexpected shapes (n_in %d, in0 %d, out %d, ws %zu); nothing launched\n", n_in, n_in > 0 ? in_sizes[0] : -1, out_size, ws_size); grid = -1; return; }
        int dev = 0, cus = 0, per_cu = 0;
        if (hipGetDevice(&dev) != hipSuccess || hipDeviceGetAttribute(&cus, hipDeviceAttributeMultiprocessorCount, dev) != hipSuccess) { grid = -1; return; }
        if (hipFuncSetAttribute((const void*)fwd_kernel, hipFuncAttributeMaxDynamicSharedMemorySize, LDS_BYTES) != hipSuccess) { fprintf(stderr, "kernel_launch: hipFuncSetAttribute failed\n"); grid = -1; return; }
        if (hipOccupancyMaxActiveBlocksPerMultiprocessor(&per_cu, (const void*)fwd_kernel, NWAVES * 64, LDS_BYTES) != hipSuccess || per_cu < 1) { fprintf(stderr, "kernel_launch: occupancy query reports %d\n", per_cu); per_cu = 1; }
        (void)hipGetLastError();
        grid = cus;
    }
    if (grid < 0) return;
    (void)hipMemsetAsync((char*)d_ws + WS_CTL, 0, CTL_ZERO_BYTES, stream);
    Args a{};
    for (int i = 0; i < 13; ++i) a.in[i] = (const float*)d_in[i];
    a.out = (float*)d_out; a.ws = (unsigned char*)d_ws;
#if MK_N_LAUNCHES == 1
    a.ph_lo = 0; a.ph_hi = N_PHASES;
    hipLaunchKernelGGL(fwd_kernel, dim3(grid), dim3(NWAVES * 64), LDS_BYTES, stream, a);
#else
    for (int p = 0; p < N_PHASES; ++p) { a.ph_lo = p; a.ph_hi = p + 1; hipLaunchKernelGGL(fwd_kernel, dim3(grid), dim3(NWAVES * 64), LDS_BYTES, stream, a); }
#endif
}
```
